# Optimizing an MI355X kernel written in HIP

```python
import jax, jax.numpy as jnp
from jax import lax
import numpy as np

D_MODEL = 1024
BATCH = 4
SEQ = 8192
DEPTH = 1
DEC_BATCH = 128
DEC_SEQ = 8
PAST_LEN = 16384
PAGE_SIZE = 128

GLA_HEADS = 8
GLA_DK = 32
GLA_DV = 64
GLA_LOW_RANK = 16
GLA_GATE_NORM = 16.0
GLA_CHUNK = 64
SWA_HEADS = 8
SWA_KV_HEADS = 2
SWA_DIM = 64
WINDOW = 128
SWA_BLOCK = 128
MIX_WIDTH = GLA_HEADS * GLA_DV + SWA_HEADS * SWA_DIM
D_FF = -(-8 * D_MODEL // (3 * 256)) * 256
PLE_DIM = 256
EPS = 1e-6
IN_SPLITS = (GLA_HEADS * GLA_DK, GLA_HEADS * GLA_DK, GLA_HEADS * GLA_DV, GLA_HEADS * GLA_DV,
             GLA_LOW_RANK, SWA_HEADS * SWA_DIM, SWA_KV_HEADS * SWA_DIM, SWA_KV_HEADS * SWA_DIM)
D_IN = sum(IN_SPLITS)

kernel_name = "hymba_gla_swa_sink_alibi_decode_step"


def rmsnorm(x, w):
    xf = x.astype(jnp.float32)
    y = xf * lax.rsqrt(jnp.mean(xf * xf, axis=-1, keepdims=True) + EPS)
    return (y * w.astype(jnp.float32)).astype(x.dtype)


def alibi_slopes(n):
    return 2.0 ** (-8.0 * jnp.arange(1, n + 1, dtype=jnp.float32) / n)


def split_points():
    return [int(c) for c in np.cumsum(IN_SPLITS)[:-1]]


def sink_softmax(s, sink):
    m = jnp.maximum(jnp.max(s, axis=-1, keepdims=True), sink)
    e = jnp.exp(s - m)
    return e / (jnp.sum(e, axis=-1, keepdims=True) + jnp.exp(sink - m))


def gla_recurrence(q, k, v, log_a, s0):
    B, T, H, DK = q.shape
    DV = v.shape[-1]
    C = min(GLA_CHUNK, T)
    n = -(-T // C)
    pad = n * C - T

    def prep(a):
        a = jnp.pad(a.astype(jnp.float32), ((0, 0), (0, pad), (0, 0), (0, 0)))
        return a.reshape(B, n, C, H, a.shape[-1]).swapaxes(0, 1)

    mask = jnp.tril(jnp.ones((C, C), dtype=bool))[None, :, :, None, None]

    def step(S, inp):
        qc, kc, vc, gc = inp
        G = jnp.cumsum(gc, axis=1)
        diff = G[:, :, None] - G[:, None, :]
        decay = jnp.exp(jnp.where(mask, diff, -jnp.inf))
        A = jnp.einsum('bihd,bjhd,bijhd->bhij', qc, kc, decay)
        o = (jnp.einsum('bhij,bjhv->bihv', A, vc)
             + jnp.einsum('bihd,bhdv->bihv', qc * jnp.exp(G), S))
        G_last = G[:, -1]
        S = (S * jnp.exp(G_last)[..., None]
             + jnp.einsum('bjhd,bjhv->bhdv', kc * jnp.exp(G_last[:, None] - G), vc))
        return S, o

    S, o = lax.scan(step, s0.astype(jnp.float32), (prep(q), prep(k), prep(v), prep(log_a)))
    o = o.swapaxes(0, 1).reshape(B, n * C, H, DV)[:, :T]
    return o, S


def swa_prompt(q, k, v, sinks, slopes):
    B, T, Hq, D = q.shape
    Hkv = k.shape[2]
    G = Hq // Hkv
    L = SWA_BLOCK
    n = T // L
    qb = q.reshape(B, n, L, Hkv, G, D)

    def band(a):
        prev = jnp.pad(a, ((0, 0), (L, 0), (0, 0), (0, 0)))[:, :T]
        return jnp.concatenate([prev.reshape(B, n, L, Hkv, D), a.reshape(B, n, L, Hkv, D)], axis=2)

    kb, vb = band(k), band(v)
    blk = jnp.arange(n)[:, None]
    qpos = blk * L + jnp.arange(L)[None]
    kpos = blk * L - L + jnp.arange(2 * L)[None]
    dist = qpos[:, :, None] - kpos[:, None, :]
    valid = (dist >= 0) & (dist < WINDOW) & (kpos[:, None, :] >= 0)
    s = jnp.einsum('bnqhgd,bnkhd->bnhgqk', qb, kb).astype(jnp.float32) * (D ** -0.5)
    s = s - slopes.reshape(Hkv, G)[:, :, None, None] * dist[:, None, None].astype(jnp.float32)
    s = jnp.where(valid[:, None, None], s, -jnp.inf)
    pr = sink_softmax(s, sinks.reshape(Hkv, G)[:, :, None, None].astype(jnp.float32))
    o = jnp.einsum('bnhgqk,bnkhd->bnqhgd', pr.astype(v.dtype), vb)
    return o.reshape(B, T, Hq * D)


def swa_with_buffer(q, k, v, k_buf, v_buf, sinks, slopes):
    B, T, Hq, D = q.shape
    Hkv = k.shape[2]
    G = Hq // Hkv
    Wb = k_buf.shape[1]
    kk = jnp.concatenate([k_buf.astype(k.dtype), k], axis=1)
    vv = jnp.concatenate([v_buf.astype(v.dtype), v], axis=1)
    qpos = Wb + jnp.arange(T)
    kpos = jnp.arange(Wb + T)
    dist = qpos[:, None] - kpos[None, :]
    valid = (dist >= 0) & (dist < WINDOW)
    qg = q.reshape(B, T, Hkv, G, D)
    s = jnp.einsum('bqhgd,bkhd->bhgqk', qg, kk).astype(jnp.float32) * (D ** -0.5)
    s = s - slopes.reshape(Hkv, G)[:, :, None, None] * dist.astype(jnp.float32)
    s = jnp.where(valid, s, -jnp.inf)
    pr = sink_softmax(s, sinks.reshape(Hkv, G)[:, :, None, None].astype(jnp.float32))
    o = jnp.einsum('bhgqk,bkhd->bqhgd', pr.astype(vv.dtype), vv).reshape(B, T, Hq * D)
    return o, kk[:, -Wb:], vv[:, -Wb:]


def trunk_layer(x, p, gla_s0, k_buf, v_buf,
                w_pre_mix, w_in, gla_gate_up, gla_gate_b, gla_norm_w, swa_sinks, w_out,
                w_post_mix, w_pre_ffn, w_gate, w_up, w_down, w_post_ffn, w_ple_gate, w_ple_proj,
                is_prompt):
    B, T, _ = x.shape
    hn = rmsnorm(x, w_pre_mix)
    z = hn @ w_in
    q_g, k_g, v_g, og_g, lr_g, q_s, k_s, v_s = jnp.split(z, split_points(), axis=-1)

    log_a = jax.nn.log_sigmoid((lr_g @ gla_gate_up + gla_gate_b).astype(jnp.float32)) / GLA_GATE_NORM
    if gla_s0 is None:
        gla_s0 = jnp.zeros((B, GLA_HEADS, GLA_DK, GLA_DV), jnp.float32)
    o_g, s_new = gla_recurrence(q_g.reshape(B, T, GLA_HEADS, GLA_DK) * (GLA_DK ** -0.5),
                                k_g.reshape(B, T, GLA_HEADS, GLA_DK),
                                v_g.reshape(B, T, GLA_HEADS, GLA_DV),
                                log_a.reshape(B, T, GLA_HEADS, GLA_DK), gla_s0)
    o_g = rmsnorm(o_g.astype(x.dtype), gla_norm_w) * jax.nn.silu(og_g).reshape(B, T, GLA_HEADS, GLA_DV)
    o_g = o_g.reshape(B, T, GLA_HEADS * GLA_DV)

    slopes = alibi_slopes(SWA_HEADS)
    q_s = q_s.reshape(B, T, SWA_HEADS, SWA_DIM)
    k_s = k_s.reshape(B, T, SWA_KV_HEADS, SWA_DIM)
    v_s = v_s.reshape(B, T, SWA_KV_HEADS, SWA_DIM)
    if is_prompt:
        o_s = swa_prompt(q_s, k_s, v_s, swa_sinks, slopes)
        keep = min(WINDOW, T)
        k_new, v_new = k_s[:, T - keep:], v_s[:, T - keep:]
    else:
        o_s, k_new, v_new = swa_with_buffer(q_s, k_s, v_s, k_buf, v_buf, swa_sinks, slopes)
        s_new = s_new.astype(gla_s0.dtype)

    mix = jnp.concatenate([o_g, o_s.astype(x.dtype)], axis=-1) @ w_out
    h = x + rmsnorm(mix, w_post_mix)
    f = rmsnorm(h, w_pre_ffn)
    f = (jax.nn.silu(f @ w_gate) * (f @ w_up)) @ w_down
    h = h + rmsnorm(f, w_post_ffn)
    h = h + jax.nn.sigmoid(h @ w_ple_gate) * (p @ w_ple_proj)
    return h, s_new, k_new, v_new


def setup_inputs(seed: int = 0) -> dict:
    key = jax.random.key(seed)
    ks = jax.random.split(key, 24)
    f32 = jnp.float32

    def nrm(k, shape, scale):
        return jax.random.normal(k, shape, f32) * scale

    def gain(k, n):
        return 1.0 + 0.05 * jax.random.normal(k, (DEPTH, n), f32)

    w_buf = min(WINDOW, PAST_LEN)
    return {
        "x_prompt": nrm(ks[0], (BATCH, SEQ, D_MODEL), 1.0),
        "x_sample": nrm(ks[1], (DEC_BATCH, DEC_SEQ, D_MODEL), 1.0),
        "p_prompt": nrm(ks[2], (DEPTH, BATCH, SEQ, PLE_DIM), 1.0),
        "p_sample": nrm(ks[3], (DEPTH, DEC_BATCH, DEC_SEQ, PLE_DIM), 1.0),
        "state_gla": nrm(ks[4], (DEPTH, DEC_BATCH, GLA_HEADS, GLA_DK, GLA_DV), 0.5),
        "cache_swa_k": nrm(ks[5], (DEPTH, DEC_BATCH, w_buf, SWA_KV_HEADS, SWA_DIM), 1.0),
        "cache_swa_v": nrm(ks[6], (DEPTH, DEC_BATCH, w_buf, SWA_KV_HEADS, SWA_DIM), 1.0),
        "w_pre_mix": gain(ks[7], D_MODEL),
        "w_in": nrm(ks[8], (DEPTH, D_MODEL, D_IN), D_MODEL ** -0.5),
        "gla_gate_up": nrm(ks[9], (DEPTH, GLA_LOW_RANK, GLA_HEADS * GLA_DK), GLA_LOW_RANK ** -0.5),
        "gla_gate_b": nrm(ks[10], (DEPTH, GLA_HEADS * GLA_DK), 0.1),
        "gla_norm_w": gain(ks[11], GLA_DV),
        "swa_sinks": nrm(ks[12], (DEPTH, SWA_HEADS), 1.0),
        "w_out": nrm(ks[13], (DEPTH, MIX_WIDTH, D_MODEL), MIX_WIDTH ** -0.5),
        "w_post_mix": gain(ks[14], D_MODEL),
        "w_pre_ffn": gain(ks[15], D_MODEL),
        "w_gate": nrm(ks[16], (DEPTH, D_MODEL, D_FF), D_MODEL ** -0.5),
        "w_up": nrm(ks[17], (DEPTH, D_MODEL, D_FF), D_MODEL ** -0.5),
        "w_down": nrm(ks[18], (DEPTH, D_FF, D_MODEL), D_FF ** -0.5),
        "w_post_ffn": gain(ks[19], D_MODEL),
        "w_ple_gate": nrm(ks[20], (DEPTH, D_MODEL, D_MODEL), D_MODEL ** -0.5),
        "w_ple_proj": nrm(ks[21], (DEPTH, PLE_DIM, D_MODEL), PLE_DIM ** -0.5),
    }


def reference(x_prompt, x_sample, p_prompt, p_sample, state_gla, cache_swa_k, cache_swa_v,
              w_pre_mix, w_in, gla_gate_up, gla_gate_b, gla_norm_w, swa_sinks, w_out,
              w_post_mix, w_pre_ffn, w_gate, w_up, w_down, w_post_ffn, w_ple_gate, w_ple_proj):
    h_p, h_s = x_prompt, x_sample
    gla_p, k_p, v_p, gla_s, k_s, v_s = [], [], [], [], [], []
    for i in range(DEPTH):
        lw = (w_pre_mix[i], w_in[i], gla_gate_up[i], gla_gate_b[i], gla_norm_w[i], swa_sinks[i],
              w_out[i], w_post_mix[i], w_pre_ffn[i], w_gate[i], w_up[i], w_down[i], w_post_ffn[i],
              w_ple_gate[i], w_ple_proj[i])
        h_p, sg, kb, vb = trunk_layer(h_p, p_prompt[i], None, None, None, *lw, is_prompt=True)
        gla_p.append(sg); k_p.append(kb); v_p.append(vb)
        h_s, sg, kb, vb = trunk_layer(h_s, p_sample[i], state_gla[i], cache_swa_k[i], cache_swa_v[i],
                                      *lw, is_prompt=False)
        gla_s.append(sg); k_s.append(kb); v_s.append(vb)
    return (h_p, h_s, jnp.stack(gla_p), jnp.stack(k_p), jnp.stack(v_p),
            jnp.stack(gla_s), jnp.stack(k_s), jnp.stack(v_s))
```

```cpp
#include <hip/hip_runtime.h>
#include <hip/hip_cooperative_groups.h>
#include <cstdio>
namespace cg = cooperative_groups;

#define LAS __attribute__((address_space(3)))
typedef unsigned short bf16_t;
typedef short bf16x8 __attribute__((ext_vector_type(8)));
typedef float f32x4 __attribute__((ext_vector_type(4)));
typedef unsigned u32x4 __attribute__((ext_vector_type(4)));
typedef unsigned u32x2 __attribute__((ext_vector_type(2)));

constexpr int NTOK = 33792, NPROMPT = 32768, DM = 1024, DZ = 2304, DFF = 2816;
constexpr int LDS_BYTES = 131072;
constexpr float EPS = 1e-6f;

constexpr size_t O_Y = 0, O_SGP = 34603008, O_CKP = 34668544, O_CVP = 34734080, O_SGS = 34799616, O_CKS = 36896768, O_CVS = 38993920;
constexpr size_t W_XB = 0;
constexpr size_t W_Z = 69206016;
constexpr size_t W_OM = 259522560;
constexpr size_t W_MIX = 328728576;
constexpr size_t W_PB = 467140608;
constexpr size_t W_WIN = 484442112;
constexpr size_t W_WOUT = W_WIN + 4718592;
constexpr size_t W_WGU = W_WOUT + 2097152;
constexpr size_t W_WDN = W_WGU + 11534336;
constexpr size_t W_WPG = W_WDN + 5767168;
constexpr size_t W_WPP = W_WPG + 2097152;
constexpr size_t W_RSX = W_WPP + 524288;
constexpr size_t W_SS1 = W_RSX + 135168;
constexpr size_t W_SS2 = W_SS1 + 135168;
constexpr size_t W_RSH = W_SS2 + 135168;
constexpr size_t W_LR = W_RSH + 135168;
constexpr size_t W_END = W_LR + 2162688;
constexpr size_t W_DS = W_MIX;
constexpr size_t W_EGL = W_MIX + 33554432;

struct Params {
    const float* xp; const float* xs; const float* pp; const float* ps; const float* state; const float* ck; const float* cv;
    const float* w_pre_mix; const float* w_in; const float* gate_up; const float* gate_b; const float* gnw; const float* sinks;
    const float* w_out; const float* w_post_mix; const float* w_pre_ffn; const float* w_gate; const float* w_up; const float* w_down;
    const float* w_post_ffn; const float* w_ple_gate; const float* w_ple_proj;
    float* out; unsigned char* ws;
};

__device__ __forceinline__ unsigned pk_bf16(float lo, float hi) { unsigned r; asm("v_cvt_pk_bf16_f32 %0, %1, %2" : "=v"(r) : "v"(lo), "v"(hi)); return r; }
__device__ __forceinline__ float bf_lo(unsigned u) { return __uint_as_float(u << 16); }
__device__ __forceinline__ float bf_hi(unsigned u) { return __uint_as_float(u & 0xffff0000u); }
__device__ __forceinline__ float bf2f(bf16_t b) { return __uint_as_float(((unsigned)b) << 16); }
__device__ __forceinline__ bf16_t f2bf(float f) { return (bf16_t)(pk_bf16(f, 0.f) & 0xffffu); }
__device__ __forceinline__ float sigmoidf_(float x) { return 1.0f / (1.0f + __expf(-x)); }
__device__ __forceinline__ f32x4 mfma16(bf16x8 a, bf16x8 b, f32x4 c) { return __builtin_amdgcn_mfma_f32_16x16x32_bf16(a, b, c, 0, 0, 0); }
__device__ __forceinline__ bf16x8 mk8(u32x4 v) { union { u32x4 u; bf16x8 b; } x; x.u = v; return x.b; }
__device__ __forceinline__ bf16x8 mk8(u32x2 a, u32x2 b) { union { u32x4 u; bf16x8 b; } x; x.u = (u32x4){a.x, a.y, b.x, b.y}; return x.b; }

namespace pg8 {
constexpr int BM = 256, BK = 64, HALF = 128, HTB = HALF * BK * 2, NXCD = 8, WGM = 8;
__device__ __forceinline__ int lds_byte(int r, int c) { const int st = (r >> 4) * 2 + (c >> 5), rr = r & 15, cc = c & 31, ob = rr * 64 + cc * 2; return st * 1024 + (ob ^ (((ob >> 9) & 1) << 5)); }
__device__ __forceinline__ void stage_rc(int b, int& R, int& C) { const int st = b / 1024, sb = b % 1024, swz = sb ^ (((sb >> 9) & 1) << 5); R = (st >> 1) * 16 + swz / 64; C = (st & 1) * 32 + (swz % 64) / 2; }
__device__ __forceinline__ int perm32(int rho) { const int n = rho >> 4, i = rho & 15; return 8 * (i >> 2) + 4 * n + (i & 3); }
struct Unit { int pm, pn; };
struct Gemm { const bf16_t* A; const bf16_t* Bt; int M, N, K; };
struct StaticOrder {
    int nM, nN, nwg, G, c;
    __device__ void init(int M, int N, int G_, int c_) { nM = M / BM; nN = N / BM; nwg = nM * nN; G = G_; c = c_; }
    __device__ bool next(int i, Unit& u) const {
        const long L = (long)i * G + c; if (L >= nwg) return false;
        int wgid = (int)L; { const int q = nwg / NXCD, r = nwg % NXCD, xcd = wgid % NXCD, off = wgid / NXCD; wgid = (xcd < r ? xcd * (q + 1) : r * (q + 1) + (xcd - r) * q) + off; }
        const int nig = WGM * nN, gid = wgid / nig, fm = gid * WGM, gsz = (nM - fm) < WGM ? (nM - fm) : WGM;
        u.pm = fm + ((wgid % nig) % gsz); u.pn = (wgid % nig) / gsz; return true;
    }
};

template <class Epi>
__device__ __forceinline__ void gemm_phase(LAS unsigned char* lds, const Gemm g, const StaticOrder& S, const Epi& E) {
    int tid = threadIdx.x; asm volatile("" : "+v"(tid));
    const int wid = __builtin_amdgcn_readfirstlane(tid >> 6), lane = tid & 63, wr = wid >> 2, wc = wid & 3, fr = lane & 15, fq = lane >> 4;
    const int K = g.K, nt = K / BK;
    unsigned voffA[2], voffB[2];
#pragma unroll
    for (int i = 0; i < 2; ++i) { int R, C; stage_rc(tid * 16 + i * 8192, R, C); const int Rb = Epi::PERM ? ((R & ~31) + perm32(R & 31)) : R;
        voffA[i] = (unsigned)(R * K + C) * 2u; voffB[i] = (unsigned)(Rb * K + C) * 2u; }
    const size_t kstep = (size_t)(BK * 2);
    const size_t hstep = (size_t)HALF * K * 2;
    const size_t tstep = 2 * hstep;
    const unsigned ldsw = (unsigned)wid * 1024u;
    const int aoff = lds_byte(wr * 64 + fr, fq * 8), boff = lds_byte(wc * 32 + fr, fq * 8);
#define PG8_SA(b, h) (((b) * 2 + (h)) * HTB)
#define PG8_SB(b, h) ((4 + (b) * 2 + (h)) * HTB)
#define PG8_STAGE(bufoff, gbase, voff) do { _Pragma("unroll") for (int _i = 0; _i < 2; ++_i) \
        __builtin_amdgcn_global_load_lds((const unsigned*)((const char*)(gbase) + (voff)[_i]), (LAS unsigned*)(lds + (bufoff) + ldsw + _i * 8192), 16, 0, 0); } while (0)
#define PG8_LDA(dst, b, h) do { _Pragma("unroll") for (int m = 0; m < 4; ++m) _Pragma("unroll") for (int k = 0; k < 2; ++k) dst[m][k] = *(const LAS bf16x8*)(lds + PG8_SA(b, h) + aoff + m * 2048 + k * 1024); } while (0)
#define PG8_LDB(dst, b, h) do { _Pragma("unroll") for (int n = 0; n < 2; ++n) _Pragma("unroll") for (int k = 0; k < 2; ++k) dst[n][k] = *(const LAS bf16x8*)(lds + PG8_SB(b, h) + boff + n * 2048 + k * 1024); } while (0)
#define PG8_MMA(ai, bj, At, Bt) do { __builtin_amdgcn_s_setprio(1); _Pragma("unroll") for (int m = 0; m < 4; ++m) _Pragma("unroll") for (int n = 0; n < 2; ++n) _Pragma("unroll") for (int k = 0; k < 2; ++k) \
        acc[ai][bj][m][n] = __builtin_amdgcn_mfma_f32_16x16x32_bf16(Bt[n][k], At[m][k], acc[ai][bj][m][n], 0, 0, 0); __builtin_amdgcn_s_setprio(0); } while (0)
#define PG8_WAIT_V(n) asm volatile("s_waitcnt vmcnt(" #n ")" ::: "memory")
#define PG8_WAIT_L(n) asm volatile("s_waitcnt lgkmcnt(" #n ")" ::: "memory")
#define PG8_BAR __builtin_amdgcn_s_barrier()
#define PG8_SCHED __builtin_amdgcn_sched_barrier(0)
    Unit cur, nxt; int ui = 0;
    if (!S.next(0, cur)) return;
    f32x4 acc[2][2][4][2];
#pragma unroll
    for (int a = 0; a < 2; ++a)
#pragma unroll
        for (int b = 0; b < 2; ++b)
#pragma unroll
            for (int m = 0; m < 4; ++m)
#pragma unroll
                for (int n = 0; n < 2; ++n) acc[a][b][m][n] = (f32x4){0.f, 0.f, 0.f, 0.f};
    bf16x8 At[4][2], B0[2][2], B1[2][2];
    const char* cA = (const char*)g.A + (size_t)cur.pm * tstep; const char* cB = (const char*)g.Bt + (size_t)cur.pn * tstep;
    PG8_STAGE(PG8_SB(0, 0), cB, voffB); PG8_STAGE(PG8_SA(0, 0), cA, voffA); PG8_STAGE(PG8_SB(0, 1), cB + hstep, voffB); PG8_STAGE(PG8_SA(0, 1), cA + hstep, voffA);
    if (wr == 1) PG8_BAR;
    PG8_WAIT_V(4); PG8_BAR;
    PG8_STAGE(PG8_SB(1, 0), cB + kstep, voffB); PG8_STAGE(PG8_SA(1, 0), cA + kstep, voffA); PG8_STAGE(PG8_SB(1, 1), cB + hstep + kstep, voffB);
    PG8_WAIT_V(6); PG8_BAR;
    for (;;) {
        const bool has_next = S.next(ui + 1, nxt);
        const char* nA = has_next ? (const char*)g.A + (size_t)nxt.pm * tstep : cA; const char* nB = has_next ? (const char*)g.Bt + (size_t)nxt.pn * tstep : cB;
        for (int t = 0; t < nt; t += 2) {
            const bool last = (t == nt - 2);
            const char* a1 = cA + (size_t)(t + 1) * kstep;
            const char* a2 = last ? nA : cA + (size_t)(t + 2) * kstep; const char* b2 = last ? nB : cB + (size_t)(t + 2) * kstep;
            const char* a3 = a2 + kstep; const char* b3 = b2 + kstep;
            PG8_LDB(B0, 0, 0); PG8_SCHED; PG8_LDA(At, 0, 0); PG8_STAGE(PG8_SA(1, 1), a1 + hstep, voffA);
            PG8_WAIT_L(8); PG8_BAR; PG8_WAIT_L(0); PG8_MMA(0, 0, At, B0); PG8_BAR; PG8_SCHED;
            PG8_LDB(B1, 0, 1); PG8_STAGE(PG8_SB(0, 0), b2, voffB);
            PG8_BAR; PG8_WAIT_L(0); PG8_MMA(0, 1, At, B1); PG8_BAR;
            PG8_LDA(At, 0, 1); PG8_STAGE(PG8_SA(0, 0), a2, voffA);
            PG8_BAR; PG8_WAIT_L(0); PG8_MMA(1, 0, At, B0); PG8_BAR; PG8_SCHED;
            PG8_STAGE(PG8_SB(0, 1), b2 + hstep, voffB);
            PG8_WAIT_V(6); PG8_BAR; PG8_MMA(1, 1, At, B1); PG8_BAR;
            PG8_LDB(B0, 1, 0); PG8_SCHED; PG8_LDA(At, 1, 0); PG8_STAGE(PG8_SA(0, 1), a2 + hstep, voffA);
            PG8_WAIT_L(8); PG8_BAR; PG8_WAIT_L(0); PG8_MMA(0, 0, At, B0); PG8_BAR; PG8_SCHED;
            PG8_LDB(B1, 1, 1); PG8_STAGE(PG8_SB(1, 0), b3, voffB);
            PG8_BAR; PG8_WAIT_L(0); PG8_MMA(0, 1, At, B1); PG8_BAR;
            PG8_LDA(At, 1, 1); PG8_STAGE(PG8_SA(1, 0), a3, voffA);
            PG8_BAR; PG8_WAIT_L(0); PG8_MMA(1, 0, At, B0); PG8_BAR; PG8_SCHED;
            PG8_STAGE(PG8_SB(1, 1), b3 + hstep, voffB);
            PG8_WAIT_V(6); PG8_BAR; PG8_MMA(1, 1, At, B1); PG8_BAR;
        }
        E(acc, cur, wr, wc, fr, fq);
        if (!has_next) break;
#pragma unroll
        for (int a = 0; a < 2; ++a)
#pragma unroll
            for (int b = 0; b < 2; ++b)
#pragma unroll
                for (int m = 0; m < 4; ++m)
#pragma unroll
                    for (int n = 0; n < 2; ++n) acc[a][b][m][n] = (f32x4){0.f, 0.f, 0.f, 0.f};
        cur = nxt; cA = nA; cB = nB; ++ui;
    }
    PG8_WAIT_V(0);
    if (wr == 0) PG8_BAR;
    PG8_BAR;
#undef PG8_SA
#undef PG8_SB
#undef PG8_STAGE
#undef PG8_LDA
#undef PG8_LDB
#undef PG8_MMA
#undef PG8_WAIT_V
#undef PG8_WAIT_L
#undef PG8_BAR
#undef PG8_SCHED
}
}

struct EpiBf16Scale {
    static constexpr bool PERM = true;
    bf16_t* O; int ldc; const float* rs;
    __device__ __forceinline__ void operator()(const f32x4 (&acc)[2][2][4][2], const pg8::Unit& u, int wr, int wc, int fr, int fq) const {
        const int row0 = u.pm * 256 + wr * 64 + fr, col0 = u.pn * 256 + wc * 32 + 8 * fq;
#pragma unroll
        for (int ai = 0; ai < 2; ++ai)
#pragma unroll
            for (int m = 0; m < 4; ++m) {
                const int row = row0 + ai * 128 + m * 16; const float s = rs ? rs[row] : 1.0f;
                bf16_t* rowp = O + (size_t)row * ldc + col0;
#pragma unroll
                for (int bj = 0; bj < 2; ++bj) { const f32x4 v0 = acc[ai][bj][m][0] * s, v1 = acc[ai][bj][m][1] * s;
                    u32x4 w; w.x = pk_bf16(v0[0], v0[1]); w.y = pk_bf16(v0[2], v0[3]); w.z = pk_bf16(v1[0], v1[1]); w.w = pk_bf16(v1[2], v1[3]);
                    *(u32x4*)(rowp + bj * 128) = w; }
            }
    }
};
struct EpiF32SS {
    static constexpr bool PERM = false;
    float* C; float* ss;
    __device__ __forceinline__ void operator()(const f32x4 (&acc)[2][2][4][2], const pg8::Unit& u, int wr, int wc, int fr, int fq) const {
        const int row0 = u.pm * 256 + wr * 64 + fr, col0 = u.pn * 256 + wc * 32 + 4 * fq;
#pragma unroll
        for (int ai = 0; ai < 2; ++ai)
#pragma unroll
            for (int m = 0; m < 4; ++m) {
                const int row = row0 + ai * 128 + m * 16; float* rowp = C + (size_t)row * DM + col0; float s = 0.f;
#pragma unroll
                for (int bj = 0; bj < 2; ++bj)
#pragma unroll
                    for (int n = 0; n < 2; ++n) { const f32x4 v = acc[ai][bj][m][n]; *(f32x4*)(rowp + bj * 128 + n * 16) = v; s += v[0] * v[0] + v[1] * v[1] + v[2] * v[2] + v[3] * v[3]; }
                s += __shfl_xor(s, 16); s += __shfl_xor(s, 32);
                if (fq == 0) __hip_atomic_fetch_add(ss + row, s, __ATOMIC_RELAXED, __HIP_MEMORY_SCOPE_AGENT);
            }
    }
};
struct EpiAct {
    static constexpr bool PERM = true;
    bf16_t* O; const float* rs;
    __device__ __forceinline__ void operator()(const f32x4 (&acc)[2][2][4][2], const pg8::Unit& u, int wr, int wc, int fr, int fq) const {
        const int row0 = u.pm * 256 + wr * 64 + fr, col0 = u.pn * 128 + wc * 32 + 8 * fq;
#pragma unroll
        for (int ai = 0; ai < 2; ++ai)
#pragma unroll
            for (int m = 0; m < 4; ++m) {
                const int row = row0 + ai * 128 + m * 16; const float s = rs[row];
                float a[8];
#pragma unroll
                for (int n = 0; n < 2; ++n)
#pragma unroll
                    for (int j = 0; j < 4; ++j) { const float gv = acc[ai][0][m][n][j] * s, uv = acc[ai][1][m][n][j] * s; a[n * 4 + j] = gv * sigmoidf_(gv) * uv; }
                u32x4 w; w.x = pk_bf16(a[0], a[1]); w.y = pk_bf16(a[2], a[3]); w.z = pk_bf16(a[4], a[5]); w.w = pk_bf16(a[6], a[7]);
                *(u32x4*)(O + (size_t)row * DFF + col0) = w;
            }
    }
};
struct EpiOut {
    static constexpr bool PERM = false;
    float* Y; const bf16_t* PP;
    __device__ __forceinline__ void operator()(const f32x4 (&acc)[2][2][4][2], const pg8::Unit& u, int wr, int wc, int fr, int fq) const {
        const int row0 = u.pm * 256 + wr * 64 + fr, col0 = u.pn * 256 + wc * 32 + 4 * fq;
#pragma unroll
        for (int ai = 0; ai < 2; ++ai)
#pragma unroll
            for (int m = 0; m < 4; ++m) {
                const int row = row0 + ai * 128 + m * 16; float* rowp = Y + (size_t)row * DM + col0; const bf16_t* pr = PP + (size_t)row * DM + col0;
#pragma unroll
                for (int bj = 0; bj < 2; ++bj)
#pragma unroll
                    for (int n = 0; n < 2; ++n) { const f32x4 v = acc[ai][bj][m][n]; f32x4 h = *(const f32x4*)(rowp + bj * 128 + n * 16); const u32x2 pq = *(const u32x2*)(pr + bj * 128 + n * 16);
                        h[0] += sigmoidf_(v[0]) * bf_lo(pq.x); h[1] += sigmoidf_(v[1]) * bf_hi(pq.x); h[2] += sigmoidf_(v[2]) * bf_lo(pq.y); h[3] += sigmoidf_(v[3]) * bf_hi(pq.y);
                        *(f32x4*)(rowp + bj * 128 + n * 16) = h; }
            }
    }
};

template <class CM, class RM>
__device__ __forceinline__ void prep_weight(bf16_t* dst, const float* src, int ld_src, int Kdim, int Ncount, const float* scale, CM cm, RM rm, int gtid, int gthreads) {
    const int k8n = Kdim >> 3; const long total = (long)Ncount * k8n;
    for (long idx = gtid; idx < total; idx += gthreads) {
        const int n = (int)(idx % Ncount); const int k0 = (int)(idx / Ncount) * 8; const int sc = cm(n); const int dr = rm(n);
        float v[8];
#pragma unroll
        for (int j = 0; j < 8; ++j) { float x = src[(size_t)(k0 + j) * ld_src + sc]; if (scale) x *= scale[k0 + j]; v[j] = x; }
        u32x4 w; w.x = pk_bf16(v[0], v[1]); w.y = pk_bf16(v[2], v[3]); w.z = pk_bf16(v[4], v[5]); w.w = pk_bf16(v[6], v[7]);
        *(u32x4*)(dst + (size_t)dr * Kdim + k0) = w;
    }
}

__device__ __forceinline__ void phase_prep(const Params& p, LAS unsigned char* lds) {
    int tid = threadIdx.x; asm volatile("" : "+v"(tid));
    const int lane = tid & 63, wid = tid >> 6;
    const int gtid = blockIdx.x * 512 + tid, gthreads = gridDim.x * 512;
    unsigned char* ws = p.ws;
    auto idn = [](int n) { return n; };
    prep_weight((bf16_t*)(ws + W_WIN), p.w_in, 2320, 1024, 2304, p.w_pre_mix, [](int n) { return n < 1536 ? n : n + 16; }, idn, gtid, gthreads);
    prep_weight((bf16_t*)(ws + W_WOUT), p.w_out, 1024, 1024, 1024, (const float*)nullptr, idn, idn, gtid, gthreads);
    prep_weight((bf16_t*)(ws + W_WGU), p.w_gate, 2816, 1024, 2816, p.w_pre_ffn, idn, [](int n) { return (n >> 7) * 256 + (n & 127); }, gtid, gthreads);
    prep_weight((bf16_t*)(ws + W_WGU), p.w_up, 2816, 1024, 2816, p.w_pre_ffn, idn, [](int n) { return (n >> 7) * 256 + 128 + (n & 127); }, gtid, gthreads);
    prep_weight((bf16_t*)(ws + W_WDN), p.w_down, 1024, 2816, 1024, (const float*)nullptr, idn, idn, gtid, gthreads);
    prep_weight((bf16_t*)(ws + W_WPG), p.w_ple_gate, 1024, 1024, 1024, (const float*)nullptr, idn, idn, gtid, gthreads);
    prep_weight((bf16_t*)(ws + W_WPP), p.w_ple_proj, 1024, 256, 1024, (const float*)nullptr, idn, idn, gtid, gthreads);
    {
        bf16_t* pb = (bf16_t*)(ws + W_PB);
        const long total8 = (long)NTOK * 256 / 8, np8 = (long)NPROMPT * 256 / 8;
        for (long i = gtid; i < total8; i += gthreads) {
            const float* s = i < np8 ? p.pp + i * 8 : p.ps + (i - np8) * 8;
            const f32x4 a = *(const f32x4*)s, b = *(const f32x4*)(s + 4);
            u32x4 w; w.x = pk_bf16(a[0], a[1]); w.y = pk_bf16(a[2], a[3]); w.z = pk_bf16(b[0], b[1]); w.w = pk_bf16(b[2], b[3]);
            *(u32x4*)(pb + i * 8) = w;
        }
    }
    { float* ss1 = (float*)(ws + W_SS1); float* ss2 = (float*)(ws + W_SS2);
      for (int i = gtid; i < NTOK; i += gthreads) { ss1[i] = 0.f; ss2[i] = 0.f; } }
    LAS float* wl = (LAS float*)lds;
    for (int idx = tid; idx < 16384; idx += 512) { const int k = idx >> 4, j = idx & 15; wl[j * 1024 + k] = p.w_pre_mix[k] * p.w_in[(size_t)k * 2320 + 1536 + j]; }
    __syncthreads();
    bf16_t* xb = (bf16_t*)(ws + W_XB); float* rsx = (float*)(ws + W_RSX); float* lr = (float*)(ws + W_LR);
    const int gw = blockIdx.x * 8 + wid, nw = gridDim.x * 8;
    for (int r2 = gw; r2 < NTOK / 2; r2 += nw) {
        float ssq[2]; float acc[2][16];
        const float* xr[2];
#pragma unroll
        for (int rr = 0; rr < 2; ++rr) {
            const int row = r2 * 2 + rr;
            xr[rr] = row < NPROMPT ? p.xp + (size_t)row * DM : p.xs + (size_t)(row - NPROMPT) * DM;
            ssq[rr] = 0.f;
#pragma unroll
            for (int j = 0; j < 16; ++j) acc[rr][j] = 0.f;
        }
#pragma unroll 1
        for (int i = 0; i < 4; ++i) {
            f32x4 x[2];
#pragma unroll
            for (int rr = 0; rr < 2; ++rr) {
                x[rr] = *(const f32x4*)(xr[rr] + i * 256 + lane * 4); const f32x4 v = x[rr];
                ssq[rr] += v[0] * v[0] + v[1] * v[1] + v[2] * v[2] + v[3] * v[3];
                u32x2 w; w.x = pk_bf16(v[0], v[1]); w.y = pk_bf16(v[2], v[3]); *(u32x2*)(xb + (size_t)(r2 * 2 + rr) * DM + i * 256 + lane * 4) = w;
            }
#pragma unroll
            for (int j = 0; j < 16; ++j) { const f32x4 w4 = *(const LAS f32x4*)(wl + j * 1024 + i * 256 + lane * 4);
#pragma unroll
                for (int rr = 0; rr < 2; ++rr) acc[rr][j] += x[rr][0] * w4[0] + x[rr][1] * w4[1] + x[rr][2] * w4[2] + x[rr][3] * w4[3]; }
        }
#pragma unroll
        for (int rr = 0; rr < 2; ++rr) {
            const int row = r2 * 2 + rr;
            float s = ssq[rr];
#pragma unroll
            for (int o = 1; o < 64; o <<= 1) s += __shfl_xor(s, o);
            const float rstd = rsqrtf(s * (1.0f / 1024.0f) + EPS);
            float a8[8], a4[4], a2[2], a1;
            const bool b5 = lane & 32, b4 = lane & 16, b3 = lane & 8, b2 = lane & 4;
#pragma unroll
            for (int j = 0; j < 8; ++j) { const float keep = b5 ? acc[rr][j + 8] : acc[rr][j], send = b5 ? acc[rr][j] : acc[rr][j + 8]; a8[j] = keep + __shfl_xor(send, 32); }
#pragma unroll
            for (int j = 0; j < 4; ++j) { const float keep = b4 ? a8[j + 4] : a8[j], send = b4 ? a8[j] : a8[j + 4]; a4[j] = keep + __shfl_xor(send, 16); }
#pragma unroll
            for (int j = 0; j < 2; ++j) { const float keep = b3 ? a4[j + 2] : a4[j], send = b3 ? a4[j] : a4[j + 2]; a2[j] = keep + __shfl_xor(send, 8); }
            { const float keep = b2 ? a2[1] : a2[0], send = b2 ? a2[0] : a2[1]; a1 = keep + __shfl_xor(send, 4); }
            a1 += __shfl_xor(a1, 1); a1 += __shfl_xor(a1, 2);
            const int jidx = (b5 ? 8 : 0) + (b4 ? 4 : 0) + (b3 ? 2 : 0) + (b2 ? 1 : 0);
            if ((lane & 3) == 0) lr[(size_t)row * 16 + jidx] = a1 * rstd;
            if (lane == 0) rsx[row] = rstd;
        }
    }
    __syncthreads();
}

template <bool SAMPLE>
__device__ __forceinline__ void swa_item(const Params& p, LAS unsigned char* lds, int item) {
    constexpr int NQT = SAMPLE ? 1 : 2;
    int tid = threadIdx.x; asm volatile("" : "+v"(tid));
    const int lane = tid & 63, wid = __builtin_amdgcn_readfirstlane(tid >> 6), fr = lane & 15, fq = lane >> 4;
    const bf16_t* z = (const bf16_t*)(p.ws + W_Z); bf16_t* om = (bf16_t*)(p.ws + W_OM);
    int b, q0;
    if (SAMPLE) { b = item; q0 = 0; } else { b = item >> 8; q0 = (item & 255) * 32; }
    LAS unsigned char* Kl = lds; LAS unsigned char* Vl = lds + 46080;
    for (int idx = tid; idx < 2560; idx += 512) {
        const int kv = idx / 1280, rem = idx % 1280, kk = rem >> 3, ch = rem & 7;
        u32x4 kc = (u32x4){0u, 0u, 0u, 0u}, vc = (u32x4){0u, 0u, 0u, 0u};
        if (SAMPLE) {
            if (kk < 128) {
                const float* ks = p.ck + ((size_t)(b * 128 + kk) * 2 + kv) * 64 + ch * 8; const float* vs = p.cv + ((size_t)(b * 128 + kk) * 2 + kv) * 64 + ch * 8;
                const f32x4 a = *(const f32x4*)ks, c = *(const f32x4*)(ks + 4), d = *(const f32x4*)vs, e = *(const f32x4*)(vs + 4);
                kc = (u32x4){pk_bf16(a[0], a[1]), pk_bf16(a[2], a[3]), pk_bf16(c[0], c[1]), pk_bf16(c[2], c[3])};
                vc = (u32x4){pk_bf16(d[0], d[1]), pk_bf16(d[2], d[3]), pk_bf16(e[0], e[1]), pk_bf16(e[2], e[3])};
            } else if (kk < 136) {
                const bf16_t* zr = z + (size_t)(NPROMPT + b * 8 + kk - 128) * DZ;
                kc = *(const u32x4*)(zr + 2048 + kv * 64 + ch * 8); vc = *(const u32x4*)(zr + 2176 + kv * 64 + ch * 8);
            }
        } else {
            const int t = q0 - 128 + kk;
            if (t >= 0) { const bf16_t* zr = z + (size_t)(b * 8192 + t) * DZ; kc = *(const u32x4*)(zr + 2048 + kv * 64 + ch * 8); vc = *(const u32x4*)(zr + 2176 + kv * 64 + ch * 8); }
        }
        *(LAS u32x4*)(Kl + (kv * 160 + kk) * 144 + ch * 16) = kc;
        LAS bf16_t* vt = (LAS bf16_t*)Vl + (size_t)(kv * 64 + ch * 8) * 168 + kk;
        vt[0 * 168] = (bf16_t)(vc.x & 0xffffu); vt[1 * 168] = (bf16_t)(vc.x >> 16); vt[2 * 168] = (bf16_t)(vc.y & 0xffffu); vt[3 * 168] = (bf16_t)(vc.y >> 16);
        vt[4 * 168] = (bf16_t)(vc.z & 0xffffu); vt[5 * 168] = (bf16_t)(vc.z >> 16); vt[6 * 168] = (bf16_t)(vc.w & 0xffffu); vt[7 * 168] = (bf16_t)(vc.w >> 16);
    }
    __syncthreads();
    {
        const int h = wid, kv = h >> 2;
        const float slope = exp2f(-(float)(h + 1)); const float sink = p.sinks[h];
#pragma unroll 1
        for (int qt = 0; qt < NQT; ++qt) {
            bf16x8 qf[2]; size_t qrow; bool qok;
            if (SAMPLE) { qok = fr < 8; qrow = (size_t)(NPROMPT + b * 8 + (fr & 7)); } else { qok = true; qrow = (size_t)(b * 8192 + q0 + qt * 16 + fr); }
#pragma unroll
            for (int ds = 0; ds < 2; ++ds) { u32x4 v = *(const u32x4*)(z + qrow * DZ + 1536 + h * 64 + ds * 32 + fq * 8); if (!qok) v = (u32x4){0u, 0u, 0u, 0u}; qf[ds] = mk8(v); }
            f32x4 s[10];
            float mx = sink;
            const int qi = qt * 16 + fr;
#pragma unroll
            for (int kt = 0; kt < 10; ++kt) {
                const bf16x8 k0 = *(const LAS bf16x8*)(Kl + (kv * 160 + kt * 16 + fr) * 144 + fq * 16);
                const bf16x8 k1 = *(const LAS bf16x8*)(Kl + (kv * 160 + kt * 16 + fr) * 144 + 64 + fq * 16);
                f32x4 c = (f32x4){0.f, 0.f, 0.f, 0.f};
                c = mfma16(k0, qf[0], c); c = mfma16(k1, qf[1], c);
#pragma unroll
                for (int r = 0; r < 4; ++r) {
                    const int kk = kt * 16 + fq * 4 + r;
                    const bool valid = (kk > qi) && (kk <= 128 + qi) && (SAMPLE || (q0 - 128 + kk >= 0));
                    const float sv = valid ? c[r] * 0.125f - slope * (float)(128 + qi - kk) : -1e30f;
                    c[r] = sv; mx = fmaxf(mx, sv);
                }
                s[kt] = c;
            }
            float m = mx; m = fmaxf(m, __shfl_xor(m, 16)); m = fmaxf(m, __shfl_xor(m, 32));
            float sum = 0.f;
#pragma unroll
            for (int kt = 0; kt < 10; ++kt)
#pragma unroll
                for (int r = 0; r < 4; ++r) { const float e = __expf(s[kt][r] - m); s[kt][r] = e; sum += e; }
            sum += __shfl_xor(sum, 16); sum += __shfl_xor(sum, 32);
            const float den = sum + __expf(sink - m);
            f32x4 o[4];
#pragma unroll
            for (int ct = 0; ct < 4; ++ct) o[ct] = (f32x4){0.f, 0.f, 0.f, 0.f};
#pragma unroll
            for (int ks = 0; ks < 5; ++ks) {
                const f32x4 a = s[2 * ks], c = s[2 * ks + 1];
                const bf16x8 pf = mk8((u32x4){pk_bf16(a[0], a[1]), pk_bf16(a[2], a[3]), pk_bf16(c[0], c[1]), pk_bf16(c[2], c[3])});
#pragma unroll
                for (int ct = 0; ct < 4; ++ct) {
                    const LAS unsigned char* vp = Vl + ((kv * 64 + ct * 16 + fr) * 168 + ks * 32 + fq * 4) * 2;
                    const u32x2 va = *(const LAS u32x2*)vp, vb = *(const LAS u32x2*)(vp + 32);
                    o[ct] = mfma16(mk8(va, vb), pf, o[ct]);
                }
            }
            const float inv = 1.0f / den;
            if (qok) {
#pragma unroll
                for (int ct = 0; ct < 4; ++ct) { const f32x4 v = o[ct] * inv; u32x2 w; w.x = pk_bf16(v[0], v[1]); w.y = pk_bf16(v[2], v[3]);
                    *(u32x2*)(om + qrow * DM + 512 + h * 64 + ct * 16 + fq * 4) = w; }
            }
        }
    }
    __syncthreads();
}

template <bool G3>
__device__ __forceinline__ void gla_prompt_item(const Params& p, LAS unsigned char* lds, int item) {
    int tid = threadIdx.x; asm volatile("" : "+v"(tid));
    const int lane = tid & 63, wid = __builtin_amdgcn_readfirstlane(tid >> 6), fr = lane & 15, fq = lane >> 4;
    const int hl = wid >> 1, pw = wid & 1;
    const int hq = item & 1, n = (item >> 1) & 127, b = item >> 8;
    const int h = hq * 4 + hl;
    const int row0 = b * 8192 + n * 64;
    const bf16_t* z = (const bf16_t*)(p.ws + W_Z); bf16_t* om = (bf16_t*)(p.ws + W_OM);
    float* dS = (float*)(p.ws + W_DS); float* egl = (float*)(p.ws + W_EGL);
    const float* lr = (const float*)(p.ws + W_LR);
    LAS unsigned char* hb = lds + hl * 24576;
    LAS unsigned char* QT = hb; LAS unsigned char* KT = hb + 5120; LAS unsigned char* VT = hb + 10240; LAS unsigned char* ST = hb + 19456;
    const size_t ch_idx = (size_t)(b * 128 + n) * 8 + h;
    float G[16], Gl[16];
    {
        const float* lrp = lr + (size_t)(row0 + lane) * 16;
        const f32x4 l0 = *(const f32x4*)lrp, l1 = *(const f32x4*)(lrp + 4), l2 = *(const f32x4*)(lrp + 8), l3 = *(const f32x4*)(lrp + 12);
        const float lv[16] = {l0[0], l0[1], l0[2], l0[3], l1[0], l1[1], l1[2], l1[3], l2[0], l2[1], l2[2], l2[3], l3[0], l3[1], l3[2], l3[3]};
        const int cb = h * 32 + pw * 16;
#pragma unroll
        for (int dd = 0; dd < 16; ++dd) {
            float x = p.gate_b[cb + dd];
#pragma unroll
            for (int r = 0; r < 16; ++r) x += lv[r] * p.gate_up[r * 256 + cb + dd];
            float v = (fminf(x, 0.f) - __logf(1.0f + __expf(-fabsf(x)))) * (1.0f / 16.0f);
#pragma unroll
            for (int o = 1; o < 64; o <<= 1) { const float t = __shfl_up(v, o); if (lane >= o) v += t; }
            G[dd] = v; Gl[dd] = __shfl(v, 63);
        }
    }
    const bf16_t* zr = z + (size_t)(row0 + lane) * DZ;
    if (G3) {
        const u32x4 qa = *(const u32x4*)(zr + h * 32 + pw * 16), qb = *(const u32x4*)(zr + h * 32 + pw * 16 + 8);
        const u32x4 ka = *(const u32x4*)(zr + 256 + h * 32 + pw * 16), kb = *(const u32x4*)(zr + 256 + h * 32 + pw * 16 + 8);
        const unsigned qu[8] = {qa.x, qa.y, qa.z, qa.w, qb.x, qb.y, qb.z, qb.w}, ku[8] = {ka.x, ka.y, ka.z, ka.w, kb.x, kb.y, kb.z, kb.w};
        unsigned qo[8], ko[8];
        const float scale = 0.17677669529663687f;
#pragma unroll
        for (int i = 0; i < 8; ++i) {
            const float e0 = __expf(G[2 * i]), e1 = __expf(G[2 * i + 1]);
            qo[i] = pk_bf16(bf_lo(qu[i]) * scale * e0, bf_hi(qu[i]) * scale * e1);
            ko[i] = pk_bf16(bf_lo(ku[i]) * __expf(-G[2 * i]), bf_hi(ku[i]) * __expf(-G[2 * i + 1]));
        }
        *(LAS u32x4*)(QT + lane * 80 + pw * 32) = (u32x4){qo[0], qo[1], qo[2], qo[3]}; *(LAS u32x4*)(QT + lane * 80 + pw * 32 + 16) = (u32x4){qo[4], qo[5], qo[6], qo[7]};
        *(LAS u32x4*)(KT + lane * 80 + pw * 32) = (u32x4){ko[0], ko[1], ko[2], ko[3]}; *(LAS u32x4*)(KT + lane * 80 + pw * 32 + 16) = (u32x4){ko[4], ko[5], ko[6], ko[7]};
        const float* sp = dS + ch_idx * 2048 + (size_t)(pw * 16) * 64 + lane;
        unsigned so[8];
#pragma unroll
        for (int i = 0; i < 8; ++i) so[i] = pk_bf16(sp[(2 * i) * 64], sp[(2 * i + 1) * 64]);
        *(LAS u32x4*)(ST + lane * 80 + pw * 32) = (u32x4){so[0], so[1], so[2], so[3]}; *(LAS u32x4*)(ST + lane * 80 + pw * 32 + 16) = (u32x4){so[4], so[5], so[6], so[7]};
    } else {
        const u32x4 ka = *(const u32x4*)(zr + 256 + h * 32 + pw * 16), kb = *(const u32x4*)(zr + 256 + h * 32 + pw * 16 + 8);
        const unsigned ku[8] = {ka.x, ka.y, ka.z, ka.w, kb.x, kb.y, kb.z, kb.w};
#pragma unroll
        for (int i = 0; i < 8; ++i) {
            const float k0 = bf_lo(ku[i]) * __expf(Gl[2 * i] - G[2 * i]), k1 = bf_hi(ku[i]) * __expf(Gl[2 * i + 1] - G[2 * i + 1]);
            const unsigned pk = pk_bf16(k0, k1);
            *(LAS bf16_t*)(KT + (pw * 16 + 2 * i) * 144 + lane * 2) = (bf16_t)(pk & 0xffffu);
            *(LAS bf16_t*)(KT + (pw * 16 + 2 * i + 1) * 144 + lane * 2) = (bf16_t)(pk >> 16);
        }
    }
    {
        const bf16_t* vr = zr + 512 + h * 64 + pw * 32;
#pragma unroll
        for (int q4 = 0; q4 < 4; ++q4) {
            const u32x4 v = *(const u32x4*)(vr + q4 * 8);
            LAS unsigned char* vt = VT + (pw * 32 + q4 * 8) * 144 + lane * 2;
            *(LAS bf16_t*)(vt + 0 * 144) = (bf16_t)(v.x & 0xffffu); *(LAS bf16_t*)(vt + 1 * 144) = (bf16_t)(v.x >> 16);
            *(LAS bf16_t*)(vt + 2 * 144) = (bf16_t)(v.y & 0xffffu); *(LAS bf16_t*)(vt + 3 * 144) = (bf16_t)(v.y >> 16);
            *(LAS bf16_t*)(vt + 4 * 144) = (bf16_t)(v.z & 0xffffu); *(LAS bf16_t*)(vt + 5 * 144) = (bf16_t)(v.z >> 16);
            *(LAS bf16_t*)(vt + 6 * 144) = (bf16_t)(v.w & 0xffffu); *(LAS bf16_t*)(vt + 7 * 144) = (bf16_t)(v.w >> 16);
        }
    }
    __syncthreads();
    if (!G3) {
#pragma unroll
        for (int ct = 0; ct < 4; ++ct) {
            f32x4 acc = (f32x4){0.f, 0.f, 0.f, 0.f};
#pragma unroll
            for (int s = 0; s < 2; ++s) {
                const bf16x8 a = *(const LAS bf16x8*)(VT + (ct * 16 + fr) * 144 + (s * 32 + fq * 8) * 2);
                const bf16x8 bb = *(const LAS bf16x8*)(KT + (pw * 16 + fr) * 144 + (s * 32 + fq * 8) * 2);
                acc = mfma16(a, bb, acc);
            }
            *(f32x4*)(dS + ch_idx * 2048 + (size_t)(pw * 16 + fr) * 64 + ct * 16 + fq * 4) = acc;
        }
        float e = 0.f;
#pragma unroll
        for (int dd = 0; dd < 16; ++dd) e = (lane == dd) ? Gl[dd] : e;
        if (lane < 16) egl[ch_idx * 32 + pw * 16 + lane] = __expf(e);
    } else {
        const float* gnw = p.gnw;
#pragma unroll 1
        for (int ii = 0; ii < 2; ++ii) {
            const int it = ii == 0 ? pw : 3 - pw;
            const bf16x8 qf = *(const LAS bf16x8*)(QT + (it * 16 + fr) * 80 + fq * 16);
            f32x4 o[4];
#pragma unroll
            for (int ct = 0; ct < 4; ++ct) o[ct] = (f32x4){0.f, 0.f, 0.f, 0.f};
            const int nks = (it >> 1) + 1;
            const int i = it * 16 + fr;
#pragma unroll 1
            for (int s = 0; s < nks; ++s) {
                const bf16x8 k0 = *(const LAS bf16x8*)(KT + (s * 32 + fr) * 80 + fq * 16), k1 = *(const LAS bf16x8*)(KT + (s * 32 + 16 + fr) * 80 + fq * 16);
                f32x4 c0 = mfma16(k0, qf, (f32x4){0.f, 0.f, 0.f, 0.f}), c1 = mfma16(k1, qf, (f32x4){0.f, 0.f, 0.f, 0.f});
#pragma unroll
                for (int r = 0; r < 4; ++r) { const int j0 = s * 32 + fq * 4 + r; if (j0 > i) c0[r] = 0.f; if (j0 + 16 > i) c1[r] = 0.f; }
                const bf16x8 pf = mk8((u32x4){pk_bf16(c0[0], c0[1]), pk_bf16(c0[2], c0[3]), pk_bf16(c1[0], c1[1]), pk_bf16(c1[2], c1[3])});
#pragma unroll
                for (int ct = 0; ct < 4; ++ct) {
                    const LAS unsigned char* vp = VT + (ct * 16 + fr) * 144 + (s * 32 + fq * 4) * 2;
                    const u32x2 va = *(const LAS u32x2*)vp, vb = *(const LAS u32x2*)(vp + 32);
                    o[ct] = mfma16(mk8(va, vb), pf, o[ct]);
                }
            }
#pragma unroll
            for (int ct = 0; ct < 4; ++ct) { const bf16x8 sf = *(const LAS bf16x8*)(ST + (ct * 16 + fr) * 80 + fq * 16); o[ct] = mfma16(sf, qf, o[ct]); }
            float ss = 0.f;
#pragma unroll
            for (int ct = 0; ct < 4; ++ct) ss += o[ct][0] * o[ct][0] + o[ct][1] * o[ct][1] + o[ct][2] * o[ct][2] + o[ct][3] * o[ct][3];
            ss += __shfl_xor(ss, 16); ss += __shfl_xor(ss, 32);
            const float rstd = rsqrtf(ss * (1.0f / 64.0f) + EPS);
            const size_t row = (size_t)(row0 + i);
#pragma unroll
            for (int ct = 0; ct < 4; ++ct) {
                const int c = ct * 16 + fq * 4;
                const u32x2 og = *(const u32x2*)(z + row * DZ + 1024 + h * 64 + c); const f32x4 gw = *(const f32x4*)(gnw + c);
                const float g0 = bf_lo(og.x), g1 = bf_hi(og.x), g2 = bf_lo(og.y), g3 = bf_hi(og.y);
                const float v0 = o[ct][0] * rstd * gw[0] * g0 * sigmoidf_(g0), v1 = o[ct][1] * rstd * gw[1] * g1 * sigmoidf_(g1);
                const float v2 = o[ct][2] * rstd * gw[2] * g2 * sigmoidf_(g2), v3 = o[ct][3] * rstd * gw[3] * g3 * sigmoidf_(g3);
                u32x2 w; w.x = pk_bf16(v0, v1); w.y = pk_bf16(v2, v3);
                *(u32x2*)(om + row * DM + h * 64 + c) = w;
            }
        }
    }
    __syncthreads();
}

__device__ __forceinline__ void gla_scan(const Params& p) {
    int tid = threadIdx.x; asm volatile("" : "+v"(tid));
    const int gtid = blockIdx.x * 512 + tid;
    if (gtid >= 65536) return;
    float* dS = (float*)(p.ws + W_DS); const float* egl = (const float*)(p.ws + W_EGL);
    const int b = gtid >> 14, h = (gtid >> 11) & 7, e = gtid & 2047;
    float S = 0.f;
    for (int n0 = 0; n0 < 128; n0 += 16) {
        float ds[16], eg[16];
#pragma unroll
        for (int u = 0; u < 16; ++u) { const size_t ci = (size_t)(b * 128 + n0 + u) * 8 + h; ds[u] = dS[ci * 2048 + e]; eg[u] = egl[ci * 32 + (e >> 6)]; }
#pragma unroll
        for (int u = 0; u < 16; ++u) { const size_t ci = (size_t)(b * 128 + n0 + u) * 8 + h; dS[ci * 2048 + e] = S; S = S * eg[u] + ds[u]; }
    }
    p.out[O_SGP + (size_t)(b * 8 + h) * 2048 + e] = S;
}

__device__ __forceinline__ void gla_sample_pair(const Params& p, LAS unsigned char* lds, int pair) {
    int tid = threadIdx.x; asm volatile("" : "+v"(tid));
    const int half = tid >> 8, t = tid & 255;
    const int item = pair * 2 + half, b = item >> 3, h = item & 7;
    const bf16_t* z = (const bf16_t*)(p.ws + W_Z); bf16_t* om = (bf16_t*)(p.ws + W_OM); const float* lr = (const float*)(p.ws + W_LR);
    LAS float* base = (LAS float*)(lds + half * 16384);
    LAS float* q = base; LAS float* k = base + 256; LAS float* a = base + 512; LAS float* v = base + 768; LAS float* red = base + 1280;
    const int rowb = NPROMPT + b * 8;
    {
        const int tt = t >> 5, d = t & 31; const bf16_t* zr = z + (size_t)(rowb + tt) * DZ;
        q[t] = bf2f(zr[h * 32 + d]) * 0.17677669529663687f; k[t] = bf2f(zr[256 + h * 32 + d]);
        float x = p.gate_b[h * 32 + d]; const float* lp = lr + (size_t)(rowb + tt) * 16;
#pragma unroll
        for (int r = 0; r < 16; ++r) x += lp[r] * p.gate_up[r * 256 + h * 32 + d];
        a[t] = __expf((fminf(x, 0.f) - __logf(1.0f + __expf(-fabsf(x)))) * (1.0f / 16.0f));
        const int c2 = (t & 31) * 2; v[tt * 64 + c2] = bf2f(zr[512 + h * 64 + c2]); v[tt * 64 + c2 + 1] = bf2f(zr[512 + h * 64 + c2 + 1]);
    }
    __syncthreads();
    const int dv = t & 63, g = t >> 6;
    float S[8];
    const size_t sb = ((size_t)(b * 8 + h) * 32 + g * 8) * 64 + dv;
#pragma unroll
    for (int i = 0; i < 8; ++i) S[i] = p.state[sb + i * 64];
#pragma unroll
    for (int tt = 0; tt < 8; ++tt) {
        float part = 0.f; const float vv = v[tt * 64 + dv];
#pragma unroll
        for (int i = 0; i < 8; ++i) { S[i] = a[tt * 32 + g * 8 + i] * S[i] + k[tt * 32 + g * 8 + i] * vv; part += q[tt * 32 + g * 8 + i] * S[i]; }
        red[(tt * 4 + g) * 64 + dv] = part;
    }
#pragma unroll
    for (int i = 0; i < 8; ++i) p.out[O_SGS + sb + i * 64] = S[i];
    __syncthreads();
#pragma unroll
    for (int u = 0; u < 2; ++u) {
        const int tt = g * 2 + u;
        const float o = red[(tt * 4 + 0) * 64 + dv] + red[(tt * 4 + 1) * 64 + dv] + red[(tt * 4 + 2) * 64 + dv] + red[(tt * 4 + 3) * 64 + dv];
        float ss = o * o;
#pragma unroll
        for (int m = 1; m < 64; m <<= 1) ss += __shfl_xor(ss, m);
        const float rstd = rsqrtf(ss * (1.0f / 64.0f) + EPS);
        const float og = bf2f(z[(size_t)(rowb + tt) * DZ + 1024 + h * 64 + dv]);
        om[(size_t)(rowb + tt) * DM + h * 64 + dv] = f2bf(o * rstd * p.gnw[dv] * og * sigmoidf_(og));
    }
    __syncthreads();
}

__device__ __forceinline__ void cache_outputs(const Params& p) {
    int tid = threadIdx.x; asm volatile("" : "+v"(tid));
    const int gtid = blockIdx.x * 512 + tid, gthreads = gridDim.x * 512;
    const bf16_t* z = (const bf16_t*)(p.ws + W_Z);
    for (int i = gtid; i < 65536; i += gthreads) {
        const int c = i & 127, j = (i >> 7) & 127, b = i >> 14;
        const bf16_t* zr = z + (size_t)(b * 8192 + 8064 + j) * DZ;
        p.out[O_CKP + i] = bf2f(zr[2048 + c]); p.out[O_CVP + i] = bf2f(zr[2176 + c]);
    }
    for (int i = gtid; i < 2097152; i += gthreads) {
        const int c = i & 127, j = (i >> 7) & 127, b = i >> 14;
        float kvv, vvv;
        if (j < 120) { kvv = p.ck[(size_t)(b * 128 + j + 8) * 128 + c]; vvv = p.cv[(size_t)(b * 128 + j + 8) * 128 + c]; }
        else { const bf16_t* zr = z + (size_t)(NPROMPT + b * 8 + j - 120) * DZ; kvv = bf2f(zr[2048 + c]); vvv = bf2f(zr[2176 + c]); }
        p.out[O_CKS + i] = kvv; p.out[O_CVS + i] = vvv;
    }
}

template <bool SECOND>
__device__ __forceinline__ void ew_phase(const Params& p) {
    int tid = threadIdx.x; asm volatile("" : "+v"(tid));
    const int lane = tid & 63, wid = tid >> 6;
    const int gw = blockIdx.x * 8 + wid, nw = gridDim.x * 8;
    const float* br = (const float*)(p.ws + W_MIX); const float* ss = (const float*)(p.ws + (SECOND ? W_SS2 : W_SS1));
    const float* w = SECOND ? p.w_post_ffn : p.w_post_mix;
    bf16_t* hb = (bf16_t*)(p.ws + W_XB); float* rsh = (float*)(p.ws + W_RSH);
    f32x4 w4[4];
#pragma unroll
    for (int i = 0; i < 4; ++i) w4[i] = *(const f32x4*)(w + i * 256 + lane * 4);
    for (int row = gw; row < NTOK; row += nw) {
        float* yr = p.out + O_Y + (size_t)row * DM;
        const float* xr = SECOND ? yr : (row < NPROMPT ? p.xp + (size_t)row * DM : p.xs + (size_t)(row - NPROMPT) * DM);
        const float* mr = br + (size_t)row * DM;
        const float rs = rsqrtf(ss[row] * (1.0f / 1024.0f) + EPS);
        float s2 = 0.f;
#pragma unroll
        for (int i = 0; i < 4; ++i) {
            const int col = i * 256 + lane * 4;
            const f32x4 x4 = *(const f32x4*)(xr + col), m4 = *(const f32x4*)(mr + col);
            const f32x4 h4 = x4 + m4 * rs * w4[i];
            *(f32x4*)(yr + col) = h4;
            u32x2 wv; wv.x = pk_bf16(h4[0], h4[1]); wv.y = pk_bf16(h4[2], h4[3]); *(u32x2*)(hb + (size_t)row * DM + col) = wv;
            s2 += h4[0] * h4[0] + h4[1] * h4[1] + h4[2] * h4[2] + h4[3] * h4[3];
        }
        if (!SECOND) {
#pragma unroll
            for (int o = 1; o < 64; o <<= 1) s2 += __shfl_xor(s2, o);
            if (lane == 0) rsh[row] = rsqrtf(s2 * (1.0f / 1024.0f) + EPS);
        }
    }
}

__global__ void __launch_bounds__(512, 2) mega(Params p_in) {
    const Params* pq = (const Params*)__builtin_amdgcn_kernarg_segment_ptr();
#define LAUNDER() asm volatile("" : "+s"(pq))
#define p (*pq)
    extern __shared__ __attribute__((aligned(16))) unsigned char shm[];
    LAS unsigned char* lds = (LAS unsigned char*)shm;
    cg::grid_group grid = cg::this_grid();
    const int G = gridDim.x, c = blockIdx.x;
#define ws (pq->ws)

#ifndef PHASES
#define PHASES 0xffff
#endif
#define PH(k) if constexpr ((PHASES >> (k)) & 1)
    PH(0) phase_prep(p, lds);
    grid.sync(); LAUNDER();
    PH(1) { pg8::StaticOrder S; S.init(NTOK, DZ, G, c); pg8::Gemm g{(const bf16_t*)(ws + W_XB), (const bf16_t*)(ws + W_WIN), NTOK, DZ, 1024};
      EpiBf16Scale E{(bf16_t*)(ws + W_Z), DZ, (const float*)(ws + W_RSX)}; pg8::gemm_phase(lds, g, S, E); }
    grid.sync(); LAUNDER();
    PH(2) for (int it = c; it < 1024; it += G) swa_item<false>(p, lds, it);
    PH(3) for (int it = c; it < 128; it += G) swa_item<true>(p, lds, it);
    PH(4) for (int it = c; it < 1024; it += G) gla_prompt_item<false>(p, lds, it);
    PH(5) for (int it = c; it < 512; it += G) gla_sample_pair(p, lds, it);
    PH(6) cache_outputs(p);
    grid.sync(); LAUNDER();
    PH(7) gla_scan(p);
    grid.sync(); LAUNDER();
    PH(8) for (int it = c; it < 1024; it += G) gla_prompt_item<true>(p, lds, it);
    grid.sync(); LAUNDER();
    PH(9) { pg8::StaticOrder S; S.init(NTOK, DM, G, c); pg8::Gemm g{(const bf16_t*)(ws + W_OM), (const bf16_t*)(ws + W_WOUT), NTOK, DM, 1024};
      EpiF32SS E{(float*)(ws + W_MIX), (float*)(ws + W_SS1)}; pg8::gemm_phase(lds, g, S, E); }
    grid.sync(); LAUNDER();
    PH(10) ew_phase<false>(p);
    grid.sync(); LAUNDER();
    PH(11) { pg8::StaticOrder S; S.init(NTOK, 5632, G, c); pg8::Gemm g{(const bf16_t*)(ws + W_XB), (const bf16_t*)(ws + W_WGU), NTOK, 5632, 1024};
      EpiAct E{(bf16_t*)(ws + W_Z), (const float*)(ws + W_RSH)}; pg8::gemm_phase(lds, g, S, E); }
    PH(12) { pg8::StaticOrder S; S.init(NTOK, DM, G, (c + 128) % G); pg8::Gemm g{(const bf16_t*)(ws + W_PB), (const bf16_t*)(ws + W_WPP), NTOK, DM, 256};
      EpiBf16Scale E{(bf16_t*)(ws + W_OM), DM, (const float*)nullptr}; pg8::gemm_phase(lds, g, S, E); }
    grid.sync(); LAUNDER();
    PH(13) { pg8::StaticOrder S; S.init(NTOK, DM, G, c); pg8::Gemm g{(const bf16_t*)(ws + W_Z), (const bf16_t*)(ws + W_WDN), NTOK, DM, DFF};
      EpiF32SS E{(float*)(ws + W_MIX), (float*)(ws + W_SS2)}; pg8::gemm_phase(lds, g, S, E); }
    grid.sync(); LAUNDER();
    PH(14) ew_phase<true>(p);
    grid.sync(); LAUNDER();
    PH(15) { pg8::StaticOrder S; S.init(NTOK, DM, G, c); pg8::Gemm g{(const bf16_t*)(ws + W_XB), (const bf16_t*)(ws + W_WPG), NTOK, DM, 1024};
      EpiOut E{p.out + O_Y, (const bf16_t*)(ws + W_OM)}; pg8::gemm_phase(lds, g, S, E); }
#undef ws
#undef p
#undef LAUNDER
}

extern "C" void kernel_launch(void* const* d_in, const int* in_sizes, int n_in, void* d_out, int out_size, void* d_ws, size_t ws_size, hipStream_t stream) {
    static int grid_blocks = 0;
    if (!grid_blocks) {
        int dev = 0, cus = 0, per_cu = 0;
        hipGetDevice(&dev);
        hipDeviceGetAttribute(&cus, hipDeviceAttributeMultiprocessorCount, dev);
        hipFuncSetAttribute((const void*)mega, hipFuncAttributeMaxDynamicSharedMemorySize, LDS_BYTES);
        hipOccupancyMaxActiveBlocksPerMultiprocessor(&per_cu, mega, 512, LDS_BYTES);
        if (per_cu < 1) per_cu = 1;
        grid_blocks = cus;
        if (grid_blocks > cus * per_cu) grid_blocks = cus * per_cu;
        if (ws_size < W_END) fprintf(stderr, "workspace too small: %zu < %zu\n", ws_size, (size_t)W_END);
    }
    Params p{};
    p.xp = (const float*)d_in[0]; p.xs = (const float*)d_in[1]; p.pp = (const float*)d_in[2]; p.ps = (const float*)d_in[3];
    p.state = (const float*)d_in[4]; p.ck = (const float*)d_in[5]; p.cv = (const float*)d_in[6];
    p.w_pre_mix = (const float*)d_in[7]; p.w_in = (const float*)d_in[8]; p.gate_up = (const float*)d_in[9]; p.gate_b = (const float*)d_in[10];
    p.gnw = (const float*)d_in[11]; p.sinks = (const float*)d_in[12]; p.w_out = (const float*)d_in[13]; p.w_post_mix = (const float*)d_in[14];
    p.w_pre_ffn = (const float*)d_in[15]; p.w_gate = (const float*)d_in[16]; p.w_up = (const float*)d_in[17]; p.w_down = (const float*)d_in[18];
    p.w_post_ffn = (const float*)d_in[19]; p.w_ple_gate = (const float*)d_in[20]; p.w_ple_proj = (const float*)d_in[21];
    p.out = (float*)d_out; p.ws = (unsigned char*)d_ws;
    void* args[] = {&p};
    hipError_t e = hipLaunchCooperativeKernel((const void*)mega, dim3(grid_blocks), dim3(512), args, LDS_BYTES, stream);
    if (e != hipSuccess) fprintf(stderr, "cooperative launch failed: %s (grid %d)\n", hipGetErrorString(e), grid_blocks);
}
```

```cpp
#include <hip/hip_runtime.h>
#include <hip/hip_cooperative_groups.h>
#include <cstdio>
namespace cg = cooperative_groups;

#define LAS __attribute__((address_space(3)))
typedef unsigned short bf16_t;
typedef short bf16x8 __attribute__((ext_vector_type(8)));
typedef float f32x4 __attribute__((ext_vector_type(4)));
typedef unsigned u32x4 __attribute__((ext_vector_type(4)));
typedef unsigned u32x2 __attribute__((ext_vector_type(2)));

constexpr int NTOK = 33792, NPROMPT = 32768, DM = 1024, DZ = 2304, DFF = 2816;
constexpr int LDS_BYTES = 131072 + 16;
constexpr float EPS = 1e-6f;

constexpr size_t O_Y = 0, O_SGP = 34603008, O_CKP = 34668544, O_CVP = 34734080, O_SGS = 34799616, O_CKS = 36896768, O_CVS = 38993920;
constexpr size_t W_XB = 0;
constexpr size_t W_Z = 69206016;
constexpr size_t W_OM = 259522560;
constexpr size_t W_MIX = 328728576;
constexpr size_t W_PP = W_MIX + 69206016;
constexpr size_t W_PB = 467140608;
constexpr size_t W_WIN = 484442112;
constexpr size_t W_WOUT = W_WIN + 4718592;
constexpr size_t W_WGU = W_WOUT + 2097152;
constexpr size_t W_WDN = W_WGU + 11534336;
constexpr size_t W_WPG = W_WDN + 5767168;
constexpr size_t W_WPP = W_WPG + 2097152;
constexpr size_t W_RSX = W_WPP + 524288;
constexpr size_t W_SS1 = W_RSX + 135168;
constexpr size_t W_SS2 = W_SS1 + 135168;
constexpr size_t W_RSH = W_SS2 + 135168;
constexpr size_t W_LR = W_RSH + 135168;
constexpr size_t W_BAR = W_LR + 2162688;
constexpr size_t W_END = W_BAR + 16384;
constexpr size_t W_PART1 = W_Z;
constexpr size_t W_PART2 = W_OM;
constexpr size_t W_DS = W_MIX;
constexpr size_t W_EGL = W_MIX + 33554432;

struct Params {
    const float* xp; const float* xs; const float* pp; const float* ps; const float* state; const float* ck; const float* cv;
    const float* w_pre_mix; const float* w_in; const float* gate_up; const float* gate_b; const float* gnw; const float* sinks;
    const float* w_out; const float* w_post_mix; const float* w_pre_ffn; const float* w_gate; const float* w_up; const float* w_down;
    const float* w_post_ffn; const float* w_ple_gate; const float* w_ple_proj;
    float* out; unsigned char* ws;
};

__device__ __forceinline__ unsigned pk_bf16(float lo, float hi) { unsigned r; asm("v_cvt_pk_bf16_f32 %0, %1, %2" : "=v"(r) : "v"(lo), "v"(hi)); return r; }
__device__ __forceinline__ float bf_lo(unsigned u) { return __uint_as_float(u << 16); }
__device__ __forceinline__ float bf_hi(unsigned u) { return __uint_as_float(u & 0xffff0000u); }
__device__ __forceinline__ float bf2f(bf16_t b) { return __uint_as_float(((unsigned)b) << 16); }
__device__ __forceinline__ bf16_t f2bf(float f) { return (bf16_t)(pk_bf16(f, 0.f) & 0xffffu); }
__device__ __forceinline__ float sigmoidf_(float x) { return 1.0f / (1.0f + __expf(-x)); }
__device__ __forceinline__ f32x4 mfma16(bf16x8 a, bf16x8 b, f32x4 c) { return __builtin_amdgcn_mfma_f32_16x16x32_bf16(a, b, c, 0, 0, 0); }
__device__ __forceinline__ bf16x8 mk8(u32x4 v) { union { u32x4 u; bf16x8 b; } x; x.u = v; return x.b; }
__device__ __forceinline__ bf16x8 mk8(u32x2 a, u32x2 b) { union { u32x4 u; bf16x8 b; } x; x.u = (u32x4){a.x, a.y, b.x, b.y}; return x.b; }


#define XB_TMO      128
#define XB_XCNT(j)  (256  + 64 * (j))
#define XB_XSUB(j)  (1280 + 64 * (j))
#define XB_XGEN(j)  (2304 + 64 * (j))
#define XB_TOP      3328
#define XB_TOPGEN   3392
#define XCD_BAR_WORDS 3456
#define XB_SPIN_CAP (1u << 18)
__device__ __forceinline__ unsigned xb_ld(unsigned* p)              { return __hip_atomic_load(p, __ATOMIC_RELAXED, __HIP_MEMORY_SCOPE_AGENT); }
__device__ __forceinline__ unsigned xb_add(unsigned* p, unsigned v) { return __hip_atomic_fetch_add(p, v, __ATOMIC_RELAXED, __HIP_MEMORY_SCOPE_AGENT); }
__device__ __forceinline__ unsigned xb_xcc_id() { return (unsigned)__builtin_amdgcn_s_getreg((3 << 11) | 20) & 0xFu; }
#define XB_SPIN(cond, bar) do { unsigned _sp = 0; while (cond) { __builtin_amdgcn_s_sleep(1); \
    if ((++_sp & 255u) == 0u) { if (xb_ld(&(bar)[XB_TMO])) break; if (_sp > XB_SPIN_CAP) { atomicAdd(&(bar)[XB_TMO], 1u); break; } } } } while (0)
struct XcdBarrier { unsigned* bar; unsigned x; volatile LAS unsigned* st; };
__device__ __forceinline__ XcdBarrier xcd_barrier_post(unsigned* bar, volatile LAS unsigned* st) {
    XcdBarrier b; b.bar = bar; b.x = xb_xcc_id(); b.st = st;
    if (threadIdx.x == 0) (void)xb_add(&bar[XB_XCNT(b.x)], 1u);
    return b;
}
__device__ __forceinline__ void xcd_barrier_complete(unsigned* bar, unsigned x, unsigned& nloc, unsigned& nx) {
    const unsigned G = gridDim.x * gridDim.y * gridDim.z;
    unsigned sum, cnt, mine, sp = 0u;
    for (;;) {
        sum = 0u; cnt = 0u; mine = 0u;
#pragma unroll
        for (unsigned j = 0; j < 16; ++j) { const unsigned c = xb_ld(&bar[XB_XCNT(j)]); sum += c; cnt += (c > 0u) ? 1u : 0u; mine = (j == x) ? c : mine; }
        if (sum == G) break;
        __builtin_amdgcn_s_sleep(1);
        if ((++sp & 255u) == 0u) { if (xb_ld(&bar[XB_TMO])) break; if (sp > XB_SPIN_CAP) { atomicAdd(&bar[XB_TMO], 1u); break; } }
    }
    nloc = mine > 0u ? mine : 1u; nx = cnt > 0u ? cnt : 1u;
}
__device__ __forceinline__ void xcd_barrier(const XcdBarrier& b) {
    asm volatile("s_waitcnt vmcnt(0)" ::: "memory");
    __syncthreads();
    if (threadIdx.x == 0) {
        unsigned* bar = b.bar;
        __builtin_amdgcn_s_waitcnt(0);
        unsigned nloc = b.st[0], nx = b.st[1];
        if (nloc == 0u) { xcd_barrier_complete(bar, b.x, nloc, nx); b.st[0] = nloc; b.st[1] = nx; }
        const unsigned old = xb_add(&bar[XB_XSUB(b.x)], 1u);
        const unsigned gen = old / nloc;
        if (old + 1u == (gen + 1u) * nloc) {
            __builtin_amdgcn_fence(__ATOMIC_RELEASE, "agent");
            asm volatile("s_waitcnt vmcnt(0)" ::: "memory");
            const unsigned og = xb_add(&bar[XB_TOP], 1u);
            const unsigned tg = og / nx;
            if (og + 1u == (tg + 1u) * nx) xb_add(&bar[XB_TOPGEN], 1u);
            else XB_SPIN(xb_ld(&bar[XB_TOPGEN]) == tg, bar);
            __builtin_amdgcn_fence(__ATOMIC_ACQUIRE, "agent");
            xb_add(&bar[XB_XGEN(b.x)], 1u);
            asm volatile("s_waitcnt vmcnt(0)" ::: "memory");
        } else {
            XB_SPIN(xb_ld(&bar[XB_XGEN(b.x)]) == gen, bar);
            __builtin_amdgcn_fence(__ATOMIC_ACQUIRE, "agent");
            asm volatile("s_waitcnt vmcnt(0)" ::: "memory");
        }
    }
    __syncthreads();
}

namespace pg8 {
constexpr int BM = 256, BK = 64, HALF = 128, HTB = HALF * BK * 2, NXCD = 8, WGM = 8;
__device__ __forceinline__ int lds_byte(int r, int c) { const int st = (r >> 4) * 2 + (c >> 5), rr = r & 15, cc = c & 31, ob = rr * 64 + cc * 2; return st * 1024 + (ob ^ (((ob >> 9) & 1) << 5)); }
__device__ __forceinline__ void stage_rc(int b, int& R, int& C) { const int st = b / 1024, sb = b % 1024, swz = sb ^ (((sb >> 9) & 1) << 5); R = (st >> 1) * 16 + swz / 64; C = (st & 1) * 32 + (swz % 64) / 2; }
__device__ __forceinline__ int perm32(int rho) { const int n = rho >> 4, i = rho & 15; return 8 * (i >> 2) + 4 * n + (i & 3); }
struct Unit { int pm, pn, k0; };
struct Gemm { const bf16_t* A; const bf16_t* Bt; int M, N, K; };
struct StaticOrder {
    int nM, nN, nwg, G, c, nt;
    __device__ void init(int M, int N, int K, int G_, int c_) { nM = M / BM; nN = N / BM; nwg = nM * nN; G = G_; c = c_; nt = K / BK; }
    __device__ bool next(int i, Unit& u) const {
        const long L = (long)i * G + c; if (L >= nwg) return false;
        int wgid = (int)L; { const int q = nwg / NXCD, r = nwg % NXCD, xcd = wgid % NXCD, off = wgid / NXCD; wgid = (xcd < r ? xcd * (q + 1) : r * (q + 1) + (xcd - r) * q) + off; }
        const int nig = WGM * nN, gid = wgid / nig, fm = gid * WGM, gsz = (nM - fm) < WGM ? (nM - fm) : WGM;
        u.pm = fm + ((wgid % nig) % gsz); u.pn = (wgid % nig) / gsz; u.k0 = 0; return true;
    }
};
struct SplitOrder {
    int pm0, nN, nsplit, nitems, G, c, nt;
    __device__ void init(int pm0_, int npm, int nN_, int nsplit_, int nt_, int G_, int c_) { pm0 = pm0_; nN = nN_; nsplit = nsplit_; nitems = npm * nN_ * nsplit_; nt = nt_; G = G_; c = c_; }
    __device__ bool next(int i, Unit& u) const {
        if (c < 0) return false;
        const long L = (long)i * G + c; if (L >= nitems) return false;
        const int l = (int)L, sp = l % nsplit, rest = l / nsplit;
        u.pn = rest % nN; u.pm = pm0 + rest / nN; u.k0 = sp * nt; return true;
    }
};

template <class Epi, class Sched>
__device__ __forceinline__ void gemm_phase(LAS unsigned char* lds, const Gemm g, const Sched& S, const Epi& E) {
    int tid = threadIdx.x; asm volatile("" : "+v"(tid));
    const int wid = __builtin_amdgcn_readfirstlane(tid >> 6), lane = tid & 63, wr = wid >> 2, wc = wid & 3, fr = lane & 15, fq = lane >> 4;
    const int K = g.K, nt = S.nt;
    unsigned voffA[2], voffB[2];
#pragma unroll
    for (int i = 0; i < 2; ++i) { int R, C; stage_rc(tid * 16 + i * 8192, R, C); const int Rb = Epi::PERM ? ((R & ~31) + perm32(R & 31)) : R;
        voffA[i] = (unsigned)(R * K + C) * 2u; voffB[i] = (unsigned)(Rb * K + C) * 2u; }
    const size_t kstep = (size_t)(BK * 2);
    const size_t hstep = (size_t)HALF * K * 2;
    const size_t tstep = 2 * hstep;
    const unsigned ldsw = (unsigned)wid * 1024u;
    const int aoff = lds_byte(wr * 64 + fr, fq * 8), boff = lds_byte(wc * 32 + fr, fq * 8);
#define PG8_SA(b, h) (((b) * 2 + (h)) * HTB)
#define PG8_SB(b, h) ((4 + (b) * 2 + (h)) * HTB)
#define PG8_STAGE(bufoff, gbase, voff) do { _Pragma("unroll") for (int _i = 0; _i < 2; ++_i) \
        __builtin_amdgcn_global_load_lds((const unsigned*)((const char*)(gbase) + (voff)[_i]), (LAS unsigned*)(lds + (bufoff) + ldsw + _i * 8192), 16, 0, 0); } while (0)
#define PG8_LDA(dst, b, h) do { _Pragma("unroll") for (int m = 0; m < 4; ++m) _Pragma("unroll") for (int k = 0; k < 2; ++k) dst[m][k] = *(const LAS bf16x8*)(lds + PG8_SA(b, h) + aoff + m * 2048 + k * 1024); } while (0)
#define PG8_LDB(dst, b, h) do { _Pragma("unroll") for (int n = 0; n < 2; ++n) _Pragma("unroll") for (int k = 0; k < 2; ++k) dst[n][k] = *(const LAS bf16x8*)(lds + PG8_SB(b, h) + boff + n * 2048 + k * 1024); } while (0)
#define PG8_MMA(ai, bj, At, Bt) do { __builtin_amdgcn_s_setprio(1); _Pragma("unroll") for (int m = 0; m < 4; ++m) _Pragma("unroll") for (int n = 0; n < 2; ++n) _Pragma("unroll") for (int k = 0; k < 2; ++k) \
        acc[ai][bj][m][n] = __builtin_amdgcn_mfma_f32_16x16x32_bf16(Bt[n][k], At[m][k], acc[ai][bj][m][n], 0, 0, 0); __builtin_amdgcn_s_setprio(0); } while (0)
#define PG8_WAIT_V(n) asm volatile("s_waitcnt vmcnt(" #n ")" ::: "memory")
#define PG8_WAIT_L(n) asm volatile("s_waitcnt lgkmcnt(" #n ")" ::: "memory")
#define PG8_BAR __builtin_amdgcn_s_barrier()
#define PG8_SCHED __builtin_amdgcn_sched_barrier(0)
    Unit cur, nxt; int ui = 0;
    if (!S.next(0, cur)) return;
    f32x4 acc[2][2][4][2];
#pragma unroll
    for (int a = 0; a < 2; ++a)
#pragma unroll
        for (int b = 0; b < 2; ++b)
#pragma unroll
            for (int m = 0; m < 4; ++m)
#pragma unroll
                for (int n = 0; n < 2; ++n) acc[a][b][m][n] = (f32x4){0.f, 0.f, 0.f, 0.f};
    bf16x8 At[4][2], B0[2][2], B1[2][2];
    const char* cA = (const char*)g.A + (size_t)cur.pm * tstep + (size_t)cur.k0 * kstep; const char* cB = (const char*)g.Bt + (size_t)cur.pn * tstep + (size_t)cur.k0 * kstep;
    PG8_STAGE(PG8_SB(0, 0), cB, voffB); PG8_STAGE(PG8_SA(0, 0), cA, voffA); PG8_STAGE(PG8_SB(0, 1), cB + hstep, voffB); PG8_STAGE(PG8_SA(0, 1), cA + hstep, voffA);
    if (wr == 1) PG8_BAR;
    PG8_WAIT_V(4); PG8_BAR;
    PG8_STAGE(PG8_SB(1, 0), cB + kstep, voffB); PG8_STAGE(PG8_SA(1, 0), cA + kstep, voffA); PG8_STAGE(PG8_SB(1, 1), cB + hstep + kstep, voffB);
    PG8_WAIT_V(6); PG8_BAR;
    for (;;) {
        const bool has_next = S.next(ui + 1, nxt);
        const char* nA = has_next ? (const char*)g.A + (size_t)nxt.pm * tstep + (size_t)nxt.k0 * kstep : cA; const char* nB = has_next ? (const char*)g.Bt + (size_t)nxt.pn * tstep + (size_t)nxt.k0 * kstep : cB;
        for (int t = 0; t < nt; t += 2) {
            const bool last = (t == nt - 2);
            const char* a1 = cA + (size_t)(t + 1) * kstep;
            const char* a2 = last ? nA : cA + (size_t)(t + 2) * kstep; const char* b2 = last ? nB : cB + (size_t)(t + 2) * kstep;
            const char* a3 = a2 + kstep; const char* b3 = b2 + kstep;
            PG8_LDB(B0, 0, 0); PG8_SCHED; PG8_LDA(At, 0, 0); PG8_STAGE(PG8_SA(1, 1), a1 + hstep, voffA);
            PG8_WAIT_L(8); PG8_BAR; PG8_WAIT_L(0); PG8_MMA(0, 0, At, B0); PG8_BAR; PG8_SCHED;
            PG8_LDB(B1, 0, 1); PG8_STAGE(PG8_SB(0, 0), b2, voffB);
            PG8_BAR; PG8_WAIT_L(0); PG8_MMA(0, 1, At, B1); PG8_BAR;
            PG8_LDA(At, 0, 1); PG8_STAGE(PG8_SA(0, 0), a2, voffA);
            PG8_BAR; PG8_WAIT_L(0); PG8_MMA(1, 0, At, B0); PG8_BAR; PG8_SCHED;
            PG8_STAGE(PG8_SB(0, 1), b2 + hstep, voffB);
            PG8_WAIT_V(6); PG8_BAR; PG8_MMA(1, 1, At, B1); PG8_BAR;
            PG8_LDB(B0, 1, 0); PG8_SCHED; PG8_LDA(At, 1, 0); PG8_STAGE(PG8_SA(0, 1), a2 + hstep, voffA);
            PG8_WAIT_L(8); PG8_BAR; PG8_WAIT_L(0); PG8_MMA(0, 0, At, B0); PG8_BAR; PG8_SCHED;
            PG8_LDB(B1, 1, 1); PG8_STAGE(PG8_SB(1, 0), b3, voffB);
            PG8_BAR; PG8_WAIT_L(0); PG8_MMA(0, 1, At, B1); PG8_BAR;
            PG8_LDA(At, 1, 1); PG8_STAGE(PG8_SA(1, 0), a3, voffA);
            PG8_BAR; PG8_WAIT_L(0); PG8_MMA(1, 0, At, B0); PG8_BAR; PG8_SCHED;
            PG8_STAGE(PG8_SB(1, 1), b3 + hstep, voffB);
            PG8_WAIT_V(6); PG8_BAR; PG8_MMA(1, 1, At, B1); PG8_BAR;
        }
        E(acc, cur, wr, wc, fr, fq);
        if (!has_next) break;
#pragma unroll
        for (int a = 0; a < 2; ++a)
#pragma unroll
            for (int b = 0; b < 2; ++b)
#pragma unroll
                for (int m = 0; m < 4; ++m)
#pragma unroll
                    for (int n = 0; n < 2; ++n) acc[a][b][m][n] = (f32x4){0.f, 0.f, 0.f, 0.f};
        cur = nxt; cA = nA; cB = nB; ++ui;
    }
    PG8_WAIT_V(0);
    if (wr == 0) PG8_BAR;
    PG8_BAR;
#undef PG8_SA
#undef PG8_SB
#undef PG8_STAGE
#undef PG8_LDA
#undef PG8_LDB
#undef PG8_MMA
#undef PG8_WAIT_V
#undef PG8_WAIT_L
#undef PG8_BAR
#undef PG8_SCHED
}
}

struct EpiBf16Scale {
    static constexpr bool PERM = true;
    bf16_t* O; int ldc; const float* rs;
    __device__ __forceinline__ void operator()(const f32x4 (&acc)[2][2][4][2], const pg8::Unit& u, int wr, int wc, int fr, int fq) const {
        const int row0 = u.pm * 256 + wr * 64 + fr, col0 = u.pn * 256 + wc * 32 + 8 * fq;
#pragma unroll
        for (int ai = 0; ai < 2; ++ai)
#pragma unroll
            for (int m = 0; m < 4; ++m) {
                const int row = row0 + ai * 128 + m * 16; const float s = rs ? rs[row] : 1.0f;
                bf16_t* rowp = O + (size_t)row * ldc + col0;
#pragma unroll
                for (int bj = 0; bj < 2; ++bj) { const f32x4 v0 = acc[ai][bj][m][0] * s, v1 = acc[ai][bj][m][1] * s;
                    u32x4 w; w.x = pk_bf16(v0[0], v0[1]); w.y = pk_bf16(v0[2], v0[3]); w.z = pk_bf16(v1[0], v1[1]); w.w = pk_bf16(v1[2], v1[3]);
                    *(u32x4*)(rowp + bj * 128) = w; }
            }
    }
};
struct EpiF32Part {
    static constexpr bool PERM = false;
    float* P; int row_base; int nt;
    __device__ __forceinline__ void operator()(const f32x4 (&acc)[2][2][4][2], const pg8::Unit& u, int wr, int wc, int fr, int fq) const {
        const int row0 = u.pm * 256 + wr * 64 + fr - row_base, col0 = u.pn * 256 + wc * 32 + 4 * fq;
        float* base = P + (size_t)(u.k0 / nt) * 1048576;
#pragma unroll
        for (int ai = 0; ai < 2; ++ai)
#pragma unroll
            for (int m = 0; m < 4; ++m) {
                float* rowp = base + (size_t)(row0 + ai * 128 + m * 16) * DM + col0;
#pragma unroll
                for (int bj = 0; bj < 2; ++bj)
#pragma unroll
                    for (int n = 0; n < 2; ++n) *(f32x4*)(rowp + bj * 128 + n * 16) = acc[ai][bj][m][n];
            }
    }
};
struct EpiAct {
    static constexpr bool PERM = true;
    bf16_t* O; const float* rs;
    __device__ __forceinline__ void operator()(const f32x4 (&acc)[2][2][4][2], const pg8::Unit& u, int wr, int wc, int fr, int fq) const {
        const int row0 = u.pm * 256 + wr * 64 + fr, col0 = u.pn * 128 + wc * 32 + 8 * fq;
#pragma unroll
        for (int ai = 0; ai < 2; ++ai)
#pragma unroll
            for (int m = 0; m < 4; ++m) {
                const int row = row0 + ai * 128 + m * 16; const float s = rs[row];
                float a[8];
#pragma unroll
                for (int n = 0; n < 2; ++n)
#pragma unroll
                    for (int j = 0; j < 4; ++j) { const float gv = acc[ai][0][m][n][j] * s, uv = acc[ai][1][m][n][j] * s; a[n * 4 + j] = gv * sigmoidf_(gv) * uv; }
                u32x4 w; w.x = pk_bf16(a[0], a[1]); w.y = pk_bf16(a[2], a[3]); w.z = pk_bf16(a[4], a[5]); w.w = pk_bf16(a[6], a[7]);
                *(u32x4*)(O + (size_t)row * DFF + col0) = w;
            }
    }
};
struct EpiOut {
    static constexpr bool PERM = false;
    float* Y; const bf16_t* PP; const bf16_t* H2;
    __device__ __forceinline__ void operator()(const f32x4 (&acc)[2][2][4][2], const pg8::Unit& u, int wr, int wc, int fr, int fq) const {
        const int row0 = u.pm * 256 + wr * 64 + fr, col0 = u.pn * 256 + wc * 32 + 4 * fq;
#pragma unroll
        for (int ai = 0; ai < 2; ++ai)
#pragma unroll
            for (int m = 0; m < 4; ++m) {
                const int row = row0 + ai * 128 + m * 16; float* rowp = Y + (size_t)row * DM + col0; const bf16_t* pr = PP + (size_t)row * DM + col0; const bf16_t* hr = H2 + (size_t)row * DM + col0;
#pragma unroll
                for (int bj = 0; bj < 2; ++bj)
#pragma unroll
                    for (int n = 0; n < 2; ++n) { const f32x4 v = acc[ai][bj][m][n]; const u32x2 hq = *(const u32x2*)(hr + bj * 128 + n * 16); f32x4 h = (f32x4){bf_lo(hq.x), bf_hi(hq.x), bf_lo(hq.y), bf_hi(hq.y)}; const u32x2 pq = *(const u32x2*)(pr + bj * 128 + n * 16);
                        h[0] += sigmoidf_(v[0]) * bf_lo(pq.x); h[1] += sigmoidf_(v[1]) * bf_hi(pq.x); h[2] += sigmoidf_(v[2]) * bf_lo(pq.y); h[3] += sigmoidf_(v[3]) * bf_hi(pq.y);
                        *(f32x4*)(rowp + bj * 128 + n * 16) = h; }
            }
    }
};

template <class CM, class RM>
__device__ __forceinline__ void prep_weight(bf16_t* dst, const float* src, int ld_src, int Kdim, int Ncount, const float* scale, CM cm, RM rm, int gtid, int gthreads) {
    const int k8n = Kdim >> 3; const long total = (long)Ncount * k8n;
    for (long idx = gtid; idx < total; idx += gthreads) {
        const int n = (int)(idx % Ncount); const int k0 = (int)(idx / Ncount) * 8; const int sc = cm(n); const int dr = rm(n);
        float v[8];
#pragma unroll
        for (int j = 0; j < 8; ++j) { float x = src[(size_t)(k0 + j) * ld_src + sc]; if (scale) x *= scale[k0 + j]; v[j] = x; }
        u32x4 w; w.x = pk_bf16(v[0], v[1]); w.y = pk_bf16(v[2], v[3]); w.z = pk_bf16(v[4], v[5]); w.w = pk_bf16(v[6], v[7]);
        *(u32x4*)(dst + (size_t)dr * Kdim + k0) = w;
    }
}

__device__ __forceinline__ void phase_prep(const Params& p, LAS unsigned char* lds) {
    int tid = threadIdx.x; asm volatile("" : "+v"(tid));
    const int lane = tid & 63, wid = tid >> 6;
    const int gtid = blockIdx.x * 512 + tid, gthreads = gridDim.x * 512;
    unsigned char* ws = p.ws;
    auto idn = [](int n) { return n; };
    prep_weight((bf16_t*)(ws + W_WIN), p.w_in, 2320, 1024, 2304, p.w_pre_mix, [](int n) { return n < 1536 ? n : n + 16; }, idn, gtid, gthreads);
    prep_weight((bf16_t*)(ws + W_WOUT), p.w_out, 1024, 1024, 1024, (const float*)nullptr, idn, idn, gtid, gthreads);
    prep_weight((bf16_t*)(ws + W_WGU), p.w_gate, 2816, 1024, 2816, p.w_pre_ffn, idn, [](int n) { return (n >> 7) * 256 + (n & 127); }, gtid, gthreads);
    prep_weight((bf16_t*)(ws + W_WGU), p.w_up, 2816, 1024, 2816, p.w_pre_ffn, idn, [](int n) { return (n >> 7) * 256 + 128 + (n & 127); }, gtid, gthreads);
    prep_weight((bf16_t*)(ws + W_WDN), p.w_down, 1024, 2816, 1024, (const float*)nullptr, idn, idn, gtid, gthreads);
    prep_weight((bf16_t*)(ws + W_WPG), p.w_ple_gate, 1024, 1024, 1024, (const float*)nullptr, idn, idn, gtid, gthreads);
    prep_weight((bf16_t*)(ws + W_WPP), p.w_ple_proj, 1024, 256, 1024, (const float*)nullptr, idn, idn, gtid, gthreads);
    {
        bf16_t* pb = (bf16_t*)(ws + W_PB);
        const long total8 = (long)NTOK * 256 / 8, np8 = (long)NPROMPT * 256 / 8;
        for (long i = gtid; i < total8; i += gthreads) {
            const float* s = i < np8 ? p.pp + i * 8 : p.ps + (i - np8) * 8;
            const f32x4 a = *(const f32x4*)s, b = *(const f32x4*)(s + 4);
            u32x4 w; w.x = pk_bf16(a[0], a[1]); w.y = pk_bf16(a[2], a[3]); w.z = pk_bf16(b[0], b[1]); w.w = pk_bf16(b[2], b[3]);
            *(u32x4*)(pb + i * 8) = w;
        }
    }
    LAS float* wl = (LAS float*)lds;
    for (int idx = tid; idx < 16384; idx += 512) { const int k = idx >> 4, j = idx & 15; wl[j * 1024 + k] = p.w_pre_mix[k] * p.w_in[(size_t)k * 2320 + 1536 + j]; }
    __syncthreads();
    bf16_t* xb = (bf16_t*)(ws + W_XB); float* rsx = (float*)(ws + W_RSX); float* lr = (float*)(ws + W_LR);
    const int gw = blockIdx.x * 8 + wid, nw = gridDim.x * 8;
    for (int row = gw; row < NTOK; row += nw) {
        const float* xr = row < NPROMPT ? p.xp + (size_t)row * DM : p.xs + (size_t)(row - NPROMPT) * DM;
        f32x4 x[4]; float acc[16]; float s = 0.f;
#pragma unroll
        for (int i = 0; i < 4; ++i) x[i] = *(const f32x4*)(xr + i * 256 + lane * 4);
#pragma unroll
        for (int j = 0; j < 16; ++j) acc[j] = 0.f;
#pragma unroll
        for (int i = 0; i < 4; ++i) {
            const f32x4 v = x[i];
            s += v[0] * v[0] + v[1] * v[1] + v[2] * v[2] + v[3] * v[3];
            u32x2 w; w.x = pk_bf16(v[0], v[1]); w.y = pk_bf16(v[2], v[3]); *(u32x2*)(xb + (size_t)row * DM + i * 256 + lane * 4) = w;
#pragma unroll
            for (int j = 0; j < 16; ++j) { const f32x4 w4 = *(const LAS f32x4*)(wl + j * 1024 + i * 256 + lane * 4); acc[j] += v[0] * w4[0] + v[1] * w4[1] + v[2] * w4[2] + v[3] * w4[3]; }
            __builtin_amdgcn_sched_barrier(0);
        }
#pragma unroll
        for (int o = 1; o < 64; o <<= 1) s += __shfl_xor(s, o);
        const float rstd = rsqrtf(s * (1.0f / 1024.0f) + EPS);
        float a8[8], a4[4], a2[2], a1;
        const bool b5 = lane & 32, b4 = lane & 16, b3 = lane & 8, b2 = lane & 4;
#pragma unroll
        for (int j = 0; j < 8; ++j) { const float keep = b5 ? acc[j + 8] : acc[j], send = b5 ? acc[j] : acc[j + 8]; a8[j] = keep + __shfl_xor(send, 32); }
#pragma unroll
        for (int j = 0; j < 4; ++j) { const float keep = b4 ? a8[j + 4] : a8[j], send = b4 ? a8[j] : a8[j + 4]; a4[j] = keep + __shfl_xor(send, 16); }
#pragma unroll
        for (int j = 0; j < 2; ++j) { const float keep = b3 ? a4[j + 2] : a4[j], send = b3 ? a4[j] : a4[j + 2]; a2[j] = keep + __shfl_xor(send, 8); }
        { const float keep = b2 ? a2[1] : a2[0], send = b2 ? a2[0] : a2[1]; a1 = keep + __shfl_xor(send, 4); }
        a1 += __shfl_xor(a1, 1); a1 += __shfl_xor(a1, 2);
        const int jidx = (b5 ? 8 : 0) + (b4 ? 4 : 0) + (b3 ? 2 : 0) + (b2 ? 1 : 0);
        if ((lane & 3) == 0) lr[(size_t)row * 16 + jidx] = a1 * rstd;
        if (lane == 0) rsx[row] = rstd;
    }
    __syncthreads();
}

template <bool SAMPLE>
__device__ __forceinline__ void swa_item(const Params& p, LAS unsigned char* lds, int item) {
    constexpr int NQT = SAMPLE ? 1 : 2;
    int tid = threadIdx.x; asm volatile("" : "+v"(tid));
    const int lane = tid & 63, wid = __builtin_amdgcn_readfirstlane(tid >> 6), fr = lane & 15, fq = lane >> 4;
    const bf16_t* z = (const bf16_t*)(p.ws + W_Z); bf16_t* om = (bf16_t*)(p.ws + W_OM);
    int b, q0;
    if (SAMPLE) { b = item; q0 = 0; } else { b = item >> 8; q0 = (item & 255) * 32; }
    LAS unsigned char* Kl = lds; LAS unsigned char* Vl = lds + 46080;
    for (int idx = tid; idx < 2560; idx += 512) {
        const int kv = idx / 1280, rem = idx % 1280, kk = rem >> 3, ch = rem & 7;
        u32x4 kc = (u32x4){0u, 0u, 0u, 0u}, vc = (u32x4){0u, 0u, 0u, 0u};
        if (SAMPLE) {
            if (kk < 128) {
                const float* ks = p.ck + ((size_t)(b * 128 + kk) * 2 + kv) * 64 + ch * 8; const float* vs = p.cv + ((size_t)(b * 128 + kk) * 2 + kv) * 64 + ch * 8;
                const f32x4 a = *(const f32x4*)ks, c = *(const f32x4*)(ks + 4), d = *(const f32x4*)vs, e = *(const f32x4*)(vs + 4);
                kc = (u32x4){pk_bf16(a[0], a[1]), pk_bf16(a[2], a[3]), pk_bf16(c[0], c[1]), pk_bf16(c[2], c[3])};
                vc = (u32x4){pk_bf16(d[0], d[1]), pk_bf16(d[2], d[3]), pk_bf16(e[0], e[1]), pk_bf16(e[2], e[3])};
            } else if (kk < 136) {
                const bf16_t* zr = z + (size_t)(NPROMPT + b * 8 + kk - 128) * DZ;
                kc = *(const u32x4*)(zr + 2048 + kv * 64 + ch * 8); vc = *(const u32x4*)(zr + 2176 + kv * 64 + ch * 8);
            }
        } else {
            const int t = q0 - 128 + kk;
            if (t >= 0) { const bf16_t* zr = z + (size_t)(b * 8192 + t) * DZ; kc = *(const u32x4*)(zr + 2048 + kv * 64 + ch * 8); vc = *(const u32x4*)(zr + 2176 + kv * 64 + ch * 8); }
        }
        *(LAS u32x4*)(Kl + (kv * 160 + kk) * 144 + ch * 16) = kc;
        LAS bf16_t* vt = (LAS bf16_t*)Vl + (size_t)(kv * 64 + ch * 8) * 168 + kk;
        vt[0 * 168] = (bf16_t)(vc.x & 0xffffu); vt[1 * 168] = (bf16_t)(vc.x >> 16); vt[2 * 168] = (bf16_t)(vc.y & 0xffffu); vt[3 * 168] = (bf16_t)(vc.y >> 16);
        vt[4 * 168] = (bf16_t)(vc.z & 0xffffu); vt[5 * 168] = (bf16_t)(vc.z >> 16); vt[6 * 168] = (bf16_t)(vc.w & 0xffffu); vt[7 * 168] = (bf16_t)(vc.w >> 16);
    }
    __syncthreads();
    {
        const int h = wid, kv = h >> 2;
        const float slope = exp2f(-(float)(h + 1)); const float sink = p.sinks[h];
#pragma unroll 1
        for (int qt = 0; qt < NQT; ++qt) {
            bf16x8 qf[2]; size_t qrow; bool qok;
            if (SAMPLE) { qok = fr < 8; qrow = (size_t)(NPROMPT + b * 8 + (fr & 7)); } else { qok = true; qrow = (size_t)(b * 8192 + q0 + qt * 16 + fr); }
#pragma unroll
            for (int ds = 0; ds < 2; ++ds) { u32x4 v = *(const u32x4*)(z + qrow * DZ + 1536 + h * 64 + ds * 32 + fq * 8); if (!qok) v = (u32x4){0u, 0u, 0u, 0u}; qf[ds] = mk8(v); }
            f32x4 s[10];
            float mx = sink;
            const int qi = qt * 16 + fr;
#pragma unroll
            for (int kt = 0; kt < 10; ++kt) {
                const bf16x8 k0 = *(const LAS bf16x8*)(Kl + (kv * 160 + kt * 16 + fr) * 144 + fq * 16);
                const bf16x8 k1 = *(const LAS bf16x8*)(Kl + (kv * 160 + kt * 16 + fr) * 144 + 64 + fq * 16);
                f32x4 c = (f32x4){0.f, 0.f, 0.f, 0.f};
                c = mfma16(k0, qf[0], c); c = mfma16(k1, qf[1], c);
#pragma unroll
                for (int r = 0; r < 4; ++r) {
                    const int kk = kt * 16 + fq * 4 + r;
                    const bool valid = (kk > qi) && (kk <= 128 + qi) && (SAMPLE || (q0 - 128 + kk >= 0));
                    const float sv = valid ? c[r] * 0.125f - slope * (float)(128 + qi - kk) : -1e30f;
                    c[r] = sv; mx = fmaxf(mx, sv);
                }
                s[kt] = c;
            }
            float m = mx; m = fmaxf(m, __shfl_xor(m, 16)); m = fmaxf(m, __shfl_xor(m, 32));
            float sum = 0.f;
#pragma unroll
            for (int kt = 0; kt < 10; ++kt)
#pragma unroll
                for (int r = 0; r < 4; ++r) { const float e = __expf(s[kt][r] - m); s[kt][r] = e; sum += e; }
            sum += __shfl_xor(sum, 16); sum += __shfl_xor(sum, 32);
            const float den = sum + __expf(sink - m);
            f32x4 o[4];
#pragma unroll
            for (int ct = 0; ct < 4; ++ct) o[ct] = (f32x4){0.f, 0.f, 0.f, 0.f};
#pragma unroll
            for (int ks = 0; ks < 5; ++ks) {
                const f32x4 a = s[2 * ks], c = s[2 * ks + 1];
                const bf16x8 pf = mk8((u32x4){pk_bf16(a[0], a[1]), pk_bf16(a[2], a[3]), pk_bf16(c[0], c[1]), pk_bf16(c[2], c[3])});
#pragma unroll
                for (int ct = 0; ct < 4; ++ct) {
                    const LAS unsigned char* vp = Vl + ((kv * 64 + ct * 16 + fr) * 168 + ks * 32 + fq * 4) * 2;
                    const u32x2 va = *(const LAS u32x2*)vp, vb = *(const LAS u32x2*)(vp + 32);
                    o[ct] = mfma16(mk8(va, vb), pf, o[ct]);
                }
            }
            const float inv = 1.0f / den;
            if (qok) {
#pragma unroll
                for (int ct = 0; ct < 4; ++ct) { const f32x4 v = o[ct] * inv; u32x2 w; w.x = pk_bf16(v[0], v[1]); w.y = pk_bf16(v[2], v[3]);
                    *(u32x2*)(om + qrow * DM + 512 + h * 64 + ct * 16 + fq * 4) = w; }
            }
        }
    }
    __syncthreads();
}

template <bool G3>
__device__ __forceinline__ void gla_prompt_item(const Params& p, LAS unsigned char* lds, int item) {
    int tid = threadIdx.x; asm volatile("" : "+v"(tid));
    const int lane = tid & 63, wid = __builtin_amdgcn_readfirstlane(tid >> 6), fr = lane & 15, fq = lane >> 4;
    const int hl = wid >> 1, pw = wid & 1;
    const int hq = item & 1, n = (item >> 1) & 127, b = item >> 8;
    const int h = hq * 4 + hl;
    const int row0 = b * 8192 + n * 64;
    const bf16_t* z = (const bf16_t*)(p.ws + W_Z); bf16_t* om = (bf16_t*)(p.ws + W_OM);
    float* dS = (float*)(p.ws + W_DS); float* egl = (float*)(p.ws + W_EGL);
    const float* lr = (const float*)(p.ws + W_LR);
    LAS unsigned char* hb = lds + hl * 24576;
    LAS unsigned char* QT = hb; LAS unsigned char* KT = hb + 5120; LAS unsigned char* VT = hb + 10240; LAS unsigned char* ST = hb + 19456;
    const size_t ch_idx = (size_t)(b * 128 + n) * 8 + h;
    float G[16], Gl[16];
    {
        const float* lrp = lr + (size_t)(row0 + lane) * 16;
        const f32x4 l0 = *(const f32x4*)lrp, l1 = *(const f32x4*)(lrp + 4), l2 = *(const f32x4*)(lrp + 8), l3 = *(const f32x4*)(lrp + 12);
        const float lv[16] = {l0[0], l0[1], l0[2], l0[3], l1[0], l1[1], l1[2], l1[3], l2[0], l2[1], l2[2], l2[3], l3[0], l3[1], l3[2], l3[3]};
        const int cb = h * 32 + pw * 16;
#pragma unroll
        for (int dd = 0; dd < 16; ++dd) {
            float x = p.gate_b[cb + dd];
#pragma unroll
            for (int r = 0; r < 16; ++r) x += lv[r] * p.gate_up[r * 256 + cb + dd];
            float v = (fminf(x, 0.f) - __logf(1.0f + __expf(-fabsf(x)))) * (1.0f / 16.0f);
#pragma unroll
            for (int o = 1; o < 64; o <<= 1) { const float t = __shfl_up(v, o); if (lane >= o) v += t; }
            G[dd] = v; Gl[dd] = __shfl(v, 63);
        }
    }
    const bf16_t* zr = z + (size_t)(row0 + lane) * DZ;
    if (G3) {
        const u32x4 qa = *(const u32x4*)(zr + h * 32 + pw * 16), qb = *(const u32x4*)(zr + h * 32 + pw * 16 + 8);
        const u32x4 ka = *(const u32x4*)(zr + 256 + h * 32 + pw * 16), kb = *(const u32x4*)(zr + 256 + h * 32 + pw * 16 + 8);
        const unsigned qu[8] = {qa.x, qa.y, qa.z, qa.w, qb.x, qb.y, qb.z, qb.w}, ku[8] = {ka.x, ka.y, ka.z, ka.w, kb.x, kb.y, kb.z, kb.w};
        unsigned qo[8], ko[8];
        const float scale = 0.17677669529663687f;
#pragma unroll
        for (int i = 0; i < 8; ++i) {
            const float e0 = __expf(G[2 * i]), e1 = __expf(G[2 * i + 1]);
            qo[i] = pk_bf16(bf_lo(qu[i]) * scale * e0, bf_hi(qu[i]) * scale * e1);
            ko[i] = pk_bf16(bf_lo(ku[i]) * __expf(-G[2 * i]), bf_hi(ku[i]) * __expf(-G[2 * i + 1]));
        }
        *(LAS u32x4*)(QT + lane * 80 + pw * 32) = (u32x4){qo[0], qo[1], qo[2], qo[3]}; *(LAS u32x4*)(QT + lane * 80 + pw * 32 + 16) = (u32x4){qo[4], qo[5], qo[6], qo[7]};
        *(LAS u32x4*)(KT + lane * 80 + pw * 32) = (u32x4){ko[0], ko[1], ko[2], ko[3]}; *(LAS u32x4*)(KT + lane * 80 + pw * 32 + 16) = (u32x4){ko[4], ko[5], ko[6], ko[7]};
        const float* sp = dS + ch_idx * 2048 + (size_t)(pw * 16) * 64 + lane;
        unsigned so[8];
#pragma unroll
        for (int i = 0; i < 8; ++i) so[i] = pk_bf16(sp[(2 * i) * 64], sp[(2 * i + 1) * 64]);
        *(LAS u32x4*)(ST + lane * 80 + pw * 32) = (u32x4){so[0], so[1], so[2], so[3]}; *(LAS u32x4*)(ST + lane * 80 + pw * 32 + 16) = (u32x4){so[4], so[5], so[6], so[7]};
    } else {
        const u32x4 ka = *(const u32x4*)(zr + 256 + h * 32 + pw * 16), kb = *(const u32x4*)(zr + 256 + h * 32 + pw * 16 + 8);
        const unsigned ku[8] = {ka.x, ka.y, ka.z, ka.w, kb.x, kb.y, kb.z, kb.w};
#pragma unroll
        for (int i = 0; i < 8; ++i) {
            const float k0 = bf_lo(ku[i]) * __expf(Gl[2 * i] - G[2 * i]), k1 = bf_hi(ku[i]) * __expf(Gl[2 * i + 1] - G[2 * i + 1]);
            const unsigned pk = pk_bf16(k0, k1);
            *(LAS bf16_t*)(KT + (pw * 16 + 2 * i) * 144 + lane * 2) = (bf16_t)(pk & 0xffffu);
            *(LAS bf16_t*)(KT + (pw * 16 + 2 * i + 1) * 144 + lane * 2) = (bf16_t)(pk >> 16);
        }
    }
    {
        const bf16_t* vr = zr + 512 + h * 64 + pw * 32;
#pragma unroll
        for (int q4 = 0; q4 < 4; ++q4) {
            const u32x4 v = *(const u32x4*)(vr + q4 * 8);
            LAS unsigned char* vt = VT + (pw * 32 + q4 * 8) * 144 + lane * 2;
            *(LAS bf16_t*)(vt + 0 * 144) = (bf16_t)(v.x & 0xffffu); *(LAS bf16_t*)(vt + 1 * 144) = (bf16_t)(v.x >> 16);
            *(LAS bf16_t*)(vt + 2 * 144) = (bf16_t)(v.y & 0xffffu); *(LAS bf16_t*)(vt + 3 * 144) = (bf16_t)(v.y >> 16);
            *(LAS bf16_t*)(vt + 4 * 144) = (bf16_t)(v.z & 0xffffu); *(LAS bf16_t*)(vt + 5 * 144) = (bf16_t)(v.z >> 16);
            *(LAS bf16_t*)(vt + 6 * 144) = (bf16_t)(v.w & 0xffffu); *(LAS bf16_t*)(vt + 7 * 144) = (bf16_t)(v.w >> 16);
        }
    }
    __syncthreads();
    if (!G3) {
#pragma unroll
        for (int ct = 0; ct < 4; ++ct) {
            f32x4 acc = (f32x4){0.f, 0.f, 0.f, 0.f};
#pragma unroll
            for (int s = 0; s < 2; ++s) {
                const bf16x8 a = *(const LAS bf16x8*)(VT + (ct * 16 + fr) * 144 + (s * 32 + fq * 8) * 2);
                const bf16x8 bb = *(const LAS bf16x8*)(KT + (pw * 16 + fr) * 144 + (s * 32 + fq * 8) * 2);
                acc = mfma16(a, bb, acc);
            }
            *(f32x4*)(dS + ch_idx * 2048 + (size_t)(pw * 16 + fr) * 64 + ct * 16 + fq * 4) = acc;
        }
        float e = 0.f;
#pragma unroll
        for (int dd = 0; dd < 16; ++dd) e = (lane == dd) ? Gl[dd] : e;
        if (lane < 16) egl[ch_idx * 32 + pw * 16 + lane] = __expf(e);
    } else {
        const float* gnw = p.gnw;
#pragma unroll 1
        for (int ii = 0; ii < 2; ++ii) {
            const int it = ii == 0 ? pw : 3 - pw;
            const bf16x8 qf = *(const LAS bf16x8*)(QT + (it * 16 + fr) * 80 + fq * 16);
            f32x4 o[4];
#pragma unroll
            for (int ct = 0; ct < 4; ++ct) o[ct] = (f32x4){0.f, 0.f, 0.f, 0.f};
            const int nks = (it >> 1) + 1;
            const int i = it * 16 + fr;
#pragma unroll 1
            for (int s = 0; s < nks; ++s) {
                const bf16x8 k0 = *(const LAS bf16x8*)(KT + (s * 32 + fr) * 80 + fq * 16), k1 = *(const LAS bf16x8*)(KT + (s * 32 + 16 + fr) * 80 + fq * 16);
                f32x4 c0 = mfma16(k0, qf, (f32x4){0.f, 0.f, 0.f, 0.f}), c1 = mfma16(k1, qf, (f32x4){0.f, 0.f, 0.f, 0.f});
#pragma unroll
                for (int r = 0; r < 4; ++r) { const int j0 = s * 32 + fq * 4 + r; if (j0 > i) c0[r] = 0.f; if (j0 + 16 > i) c1[r] = 0.f; }
                const bf16x8 pf = mk8((u32x4){pk_bf16(c0[0], c0[1]), pk_bf16(c0[2], c0[3]), pk_bf16(c1[0], c1[1]), pk_bf16(c1[2], c1[3])});
#pragma unroll
                for (int ct = 0; ct < 4; ++ct) {
                    const LAS unsigned char* vp = VT + (ct * 16 + fr) * 144 + (s * 32 + fq * 4) * 2;
                    const u32x2 va = *(const LAS u32x2*)vp, vb = *(const LAS u32x2*)(vp + 32);
                    o[ct] = mfma16(mk8(va, vb), pf, o[ct]);
                }
            }
#pragma unroll
            for (int ct = 0; ct < 4; ++ct) { const bf16x8 sf = *(const LAS bf16x8*)(ST + (ct * 16 + fr) * 80 + fq * 16); o[ct] = mfma16(sf, qf, o[ct]); }
            float ss = 0.f;
#pragma unroll
            for (int ct = 0; ct < 4; ++ct) ss += o[ct][0] * o[ct][0] + o[ct][1] * o[ct][1] + o[ct][2] * o[ct][2] + o[ct][3] * o[ct][3];
            ss += __shfl_xor(ss, 16); ss += __shfl_xor(ss, 32);
            const float rstd = rsqrtf(ss * (1.0f / 64.0f) + EPS);
            const size_t row = (size_t)(row0 + i);
#pragma unroll
            for (int ct = 0; ct < 4; ++ct) {
                const int c = ct * 16 + fq * 4;
                const u32x2 og = *(const u32x2*)(z + row * DZ + 1024 + h * 64 + c); const f32x4 gw = *(const f32x4*)(gnw + c);
                const float g0 = bf_lo(og.x), g1 = bf_hi(og.x), g2 = bf_lo(og.y), g3 = bf_hi(og.y);
                const float v0 = o[ct][0] * rstd * gw[0] * g0 * sigmoidf_(g0), v1 = o[ct][1] * rstd * gw[1] * g1 * sigmoidf_(g1);
                const float v2 = o[ct][2] * rstd * gw[2] * g2 * sigmoidf_(g2), v3 = o[ct][3] * rstd * gw[3] * g3 * sigmoidf_(g3);
                u32x2 w; w.x = pk_bf16(v0, v1); w.y = pk_bf16(v2, v3);
                *(u32x2*)(om + row * DM + h * 64 + c) = w;
            }
        }
    }
    __syncthreads();
}

__device__ __forceinline__ void gla_scan(const Params& p) {
    int tid = threadIdx.x; asm volatile("" : "+v"(tid));
    const int gtid = blockIdx.x * 512 + tid;
    if (gtid >= 65536) return;
    float* dS = (float*)(p.ws + W_DS); const float* egl = (const float*)(p.ws + W_EGL);
    const int b = gtid >> 14, h = (gtid >> 11) & 7, e = gtid & 2047;
    float S = 0.f;
    for (int n0 = 0; n0 < 128; n0 += 16) {
        float ds[16], eg[16];
#pragma unroll
        for (int u = 0; u < 16; ++u) { const size_t ci = (size_t)(b * 128 + n0 + u) * 8 + h; ds[u] = dS[ci * 2048 + e]; eg[u] = egl[ci * 32 + (e >> 6)]; }
#pragma unroll
        for (int u = 0; u < 16; ++u) { const size_t ci = (size_t)(b * 128 + n0 + u) * 8 + h; dS[ci * 2048 + e] = S; S = S * eg[u] + ds[u]; }
    }
    p.out[O_SGP + (size_t)(b * 8 + h) * 2048 + e] = S;
}

__device__ __forceinline__ void gla_sample_pair(const Params& p, LAS unsigned char* lds, int pair) {
    int tid = threadIdx.x; asm volatile("" : "+v"(tid));
    const int half = tid >> 8, t = tid & 255;
    const int item = pair * 2 + half, b = item >> 3, h = item & 7;
    const bf16_t* z = (const bf16_t*)(p.ws + W_Z); bf16_t* om = (bf16_t*)(p.ws + W_OM); const float* lr = (const float*)(p.ws + W_LR);
    LAS float* base = (LAS float*)(lds + half * 16384);
    LAS float* q = base; LAS float* k = base + 256; LAS float* a = base + 512; LAS float* v = base + 768; LAS float* red = base + 1280;
    const int rowb = NPROMPT + b * 8;
    {
        const int tt = t >> 5, d = t & 31; const bf16_t* zr = z + (size_t)(rowb + tt) * DZ;
        q[t] = bf2f(zr[h * 32 + d]) * 0.17677669529663687f; k[t] = bf2f(zr[256 + h * 32 + d]);
        float x = p.gate_b[h * 32 + d]; const float* lp = lr + (size_t)(rowb + tt) * 16;
#pragma unroll
        for (int r = 0; r < 16; ++r) x += lp[r] * p.gate_up[r * 256 + h * 32 + d];
        a[t] = __expf((fminf(x, 0.f) - __logf(1.0f + __expf(-fabsf(x)))) * (1.0f / 16.0f));
        const int c2 = (t & 31) * 2; v[tt * 64 + c2] = bf2f(zr[512 + h * 64 + c2]); v[tt * 64 + c2 + 1] = bf2f(zr[512 + h * 64 + c2 + 1]);
    }
    __syncthreads();
    const int dv = t & 63, g = t >> 6;
    float S[8];
    const size_t sb = ((size_t)(b * 8 + h) * 32 + g * 8) * 64 + dv;
#pragma unroll
    for (int i = 0; i < 8; ++i) S[i] = p.state[sb + i * 64];
#pragma unroll
    for (int tt = 0; tt < 8; ++tt) {
        float part = 0.f; const float vv = v[tt * 64 + dv];
#pragma unroll
        for (int i = 0; i < 8; ++i) { S[i] = a[tt * 32 + g * 8 + i] * S[i] + k[tt * 32 + g * 8 + i] * vv; part += q[tt * 32 + g * 8 + i] * S[i]; }
        red[(tt * 4 + g) * 64 + dv] = part;
    }
#pragma unroll
    for (int i = 0; i < 8; ++i) p.out[O_SGS + sb + i * 64] = S[i];
    __syncthreads();
#pragma unroll
    for (int u = 0; u < 2; ++u) {
        const int tt = g * 2 + u;
        const float o = red[(tt * 4 + 0) * 64 + dv] + red[(tt * 4 + 1) * 64 + dv] + red[(tt * 4 + 2) * 64 + dv] + red[(tt * 4 + 3) * 64 + dv];
        float ss = o * o;
#pragma unroll
        for (int m = 1; m < 64; m <<= 1) ss += __shfl_xor(ss, m);
        const float rstd = rsqrtf(ss * (1.0f / 64.0f) + EPS);
        const float og = bf2f(z[(size_t)(rowb + tt) * DZ + 1024 + h * 64 + dv]);
        om[(size_t)(rowb + tt) * DM + h * 64 + dv] = f2bf(o * rstd * p.gnw[dv] * og * sigmoidf_(og));
    }
    __syncthreads();
}

__device__ __forceinline__ void cache_outputs(const Params& p) {
    int tid = threadIdx.x; asm volatile("" : "+v"(tid));
    const int gtid = blockIdx.x * 512 + tid, gthreads = gridDim.x * 512;
    const bf16_t* z = (const bf16_t*)(p.ws + W_Z);
    for (int i = gtid; i < 65536; i += gthreads) {
        const int c = i & 127, j = (i >> 7) & 127, b = i >> 14;
        const bf16_t* zr = z + (size_t)(b * 8192 + 8064 + j) * DZ;
        p.out[O_CKP + i] = bf2f(zr[2048 + c]); p.out[O_CVP + i] = bf2f(zr[2176 + c]);
    }
    for (int i = gtid; i < 2097152; i += gthreads) {
        const int c = i & 127, j = (i >> 7) & 127, b = i >> 14;
        float kvv, vvv;
        if (j < 120) { kvv = p.ck[(size_t)(b * 128 + j + 8) * 128 + c]; vvv = p.cv[(size_t)(b * 128 + j + 8) * 128 + c]; }
        else { const bf16_t* zr = z + (size_t)(NPROMPT + b * 8 + j - 120) * DZ; kvv = bf2f(zr[2048 + c]); vvv = bf2f(zr[2176 + c]); }
        p.out[O_CKS + i] = kvv; p.out[O_CVS + i] = vvv;
    }
}

template <bool SECOND>
__device__ __forceinline__ void ew_phase(const Params& p) {
    int tid = threadIdx.x; asm volatile("" : "+v"(tid));
    const int lane = tid & 63, wid = tid >> 6;
    const int gw = blockIdx.x * 8 + wid, nw = gridDim.x * 8;
    constexpr int NS = SECOND ? 11 : 4;
    const bf16_t* br = (const bf16_t*)(p.ws + W_MIX); const float* part = (const float*)(p.ws + (SECOND ? W_PART2 : W_PART1));
    const float* w = SECOND ? p.w_post_ffn : p.w_post_mix;
    bf16_t* hb = (bf16_t*)(p.ws + W_XB); float* rsh = (float*)(p.ws + W_RSH);
    f32x4 w4[4];
#pragma unroll
    for (int i = 0; i < 4; ++i) w4[i] = *(const f32x4*)(w + i * 256 + lane * 4);
    for (int row = gw; row < NTOK; row += nw) {
        f32x4 m4[4], x4[4];
        if (SECOND) {
#pragma unroll
            for (int i = 0; i < 4; ++i) { const u32x2 hq = *(const u32x2*)(hb + (size_t)row * DM + i * 256 + lane * 4); x4[i] = (f32x4){bf_lo(hq.x), bf_hi(hq.x), bf_lo(hq.y), bf_hi(hq.y)}; }
        } else {
            const float* xr = row < NPROMPT ? p.xp + (size_t)row * DM : p.xs + (size_t)(row - NPROMPT) * DM;
#pragma unroll
            for (int i = 0; i < 4; ++i) x4[i] = *(const f32x4*)(xr + i * 256 + lane * 4);
        }
        if (row < NPROMPT) {
#pragma unroll
            for (int i = 0; i < 4; ++i) { const u32x2 mq = *(const u32x2*)(br + (size_t)row * DM + i * 256 + lane * 4); m4[i] = (f32x4){bf_lo(mq.x), bf_hi(mq.x), bf_lo(mq.y), bf_hi(mq.y)}; }
        } else {
            const float* pr = part + (size_t)(row - NPROMPT) * DM + lane * 4;
#pragma unroll
            for (int i = 0; i < 4; ++i) m4[i] = *(const f32x4*)(pr + i * 256);
#pragma unroll 1
            for (int sidx = 1; sidx < NS; ++sidx) {
#pragma unroll
                for (int i = 0; i < 4; ++i) m4[i] += *(const f32x4*)(pr + (size_t)sidx * 1048576 + i * 256);
            }
        }
        float s1 = 0.f;
#pragma unroll
        for (int i = 0; i < 4; ++i) s1 += m4[i][0] * m4[i][0] + m4[i][1] * m4[i][1] + m4[i][2] * m4[i][2] + m4[i][3] * m4[i][3];
#pragma unroll
        for (int o = 1; o < 64; o <<= 1) s1 += __shfl_xor(s1, o);
        const float rs = rsqrtf(s1 * (1.0f / 1024.0f) + EPS);
        float s2 = 0.f;
#pragma unroll
        for (int i = 0; i < 4; ++i) {
            const f32x4 h4 = x4[i] + m4[i] * rs * w4[i];
            u32x2 wv; wv.x = pk_bf16(h4[0], h4[1]); wv.y = pk_bf16(h4[2], h4[3]); *(u32x2*)(hb + (size_t)row * DM + i * 256 + lane * 4) = wv;
            s2 += h4[0] * h4[0] + h4[1] * h4[1] + h4[2] * h4[2] + h4[3] * h4[3];
        }
        if (!SECOND) {
#pragma unroll
            for (int o = 1; o < 64; o <<= 1) s2 += __shfl_xor(s2, o);
            if (lane == 0) rsh[row] = rsqrtf(s2 * (1.0f / 1024.0f) + EPS);
        }
    }
}

__global__ void __launch_bounds__(512, 2) mega(Params p_in) {
    const Params* pq = (const Params*)__builtin_amdgcn_kernarg_segment_ptr();
#define LAUNDER() asm volatile("" : "+s"(pq))
#define p (*pq)
    extern __shared__ __attribute__((aligned(16))) unsigned char shm[];
    LAS unsigned char* lds = (LAS unsigned char*)shm;
    cg::grid_group grid = cg::this_grid();
    const int G = gridDim.x, c = blockIdx.x;
#define ws (pq->ws)

#ifndef PHASES
#define PHASES 0xffff
#endif
#define PH(k) if constexpr ((PHASES >> (k)) & 1)
    volatile LAS unsigned* bst = (volatile LAS unsigned*)(lds + 131072);
    if (threadIdx.x == 0) { bst[0] = 0u; bst[1] = 0u; }
    __syncthreads();
    const XcdBarrier xb = xcd_barrier_post((unsigned*)(ws + W_BAR), bst);
#define GBAR() do { xcd_barrier(xb); LAUNDER(); } while (0)
    PH(0) phase_prep(p, lds);
    grid.sync(); LAUNDER();
    PH(1) { pg8::StaticOrder S; S.init(NTOK, DZ, 1024, G, c); pg8::Gemm g{(const bf16_t*)(ws + W_XB), (const bf16_t*)(ws + W_WIN), NTOK, DZ, 1024};
      EpiBf16Scale E{(bf16_t*)(ws + W_Z), DZ, (const float*)(ws + W_RSX)}; pg8::gemm_phase(lds, g, S, E); }
    GBAR();
    PH(2) for (int it = c; it < 1024; it += G) swa_item<false>(p, lds, it);
    PH(3) for (int it = c; it < 128; it += G) swa_item<true>(p, lds, it);
    PH(4) for (int it = c; it < 1024; it += G) gla_prompt_item<false>(p, lds, it);
    PH(5) for (int it = c; it < 512; it += G) gla_sample_pair(p, lds, it);
    PH(6) cache_outputs(p);
    GBAR();
    PH(7) gla_scan(p);
    GBAR();
    PH(8) for (int it = c; it < 1024; it += G) gla_prompt_item<true>(p, lds, it);
    GBAR();
    PH(9) { pg8::StaticOrder S; S.init(NPROMPT, DM, 1024, G, c); pg8::Gemm g{(const bf16_t*)(ws + W_OM), (const bf16_t*)(ws + W_WOUT), NTOK, DM, 1024};
      EpiBf16Scale E{(bf16_t*)(ws + W_MIX), DM, (const float*)nullptr}; pg8::gemm_phase(lds, g, S, E); }
    PH(9) { pg8::SplitOrder S; S.init(128, 4, 4, 4, 4, G, c - 64); pg8::Gemm g{(const bf16_t*)(ws + W_OM), (const bf16_t*)(ws + W_WOUT), NTOK, DM, 1024};
      EpiF32Part E{(float*)(ws + W_PART1), NPROMPT, 4}; pg8::gemm_phase(lds, g, S, E); }
    PH(12) { pg8::StaticOrder S; S.init(NTOK, DM, 256, G, c); pg8::Gemm g{(const bf16_t*)(ws + W_PB), (const bf16_t*)(ws + W_WPP), NTOK, DM, 256};
      EpiBf16Scale E{(bf16_t*)(ws + W_PP), DM, (const float*)nullptr}; pg8::gemm_phase(lds, g, S, E); }
    GBAR();
    PH(10) ew_phase<false>(p);
    GBAR();
    PH(11) { pg8::StaticOrder S; S.init(NTOK, 5632, 1024, G, c); pg8::Gemm g{(const bf16_t*)(ws + W_XB), (const bf16_t*)(ws + W_WGU), NTOK, 5632, 1024};
      EpiAct E{(bf16_t*)(ws + W_Z), (const float*)(ws + W_RSH)}; pg8::gemm_phase(lds, g, S, E); }
    GBAR();
    PH(13) { pg8::StaticOrder S; S.init(NPROMPT, DM, DFF, G, c); pg8::Gemm g{(const bf16_t*)(ws + W_Z), (const bf16_t*)(ws + W_WDN), NTOK, DM, DFF};
      EpiBf16Scale E{(bf16_t*)(ws + W_MIX), DM, (const float*)nullptr}; pg8::gemm_phase(lds, g, S, E); }
    PH(13) { pg8::SplitOrder S; S.init(128, 4, 4, 11, 4, G, c); pg8::Gemm g{(const bf16_t*)(ws + W_Z), (const bf16_t*)(ws + W_WDN), NTOK, DM, DFF};
      EpiF32Part E{(float*)(ws + W_PART2), NPROMPT, 4}; pg8::gemm_phase(lds, g, S, E); }
    GBAR();
    PH(14) ew_phase<true>(p);
    GBAR();
    PH(15) { pg8::StaticOrder S; S.init(NTOK, DM, 1024, G, c); pg8::Gemm g{(const bf16_t*)(ws + W_XB), (const bf16_t*)(ws + W_WPG), NTOK, DM, 1024};
      EpiOut E{p.out + O_Y, (const bf16_t*)(ws + W_PP), (const bf16_t*)(ws + W_XB)}; pg8::gemm_phase(lds, g, S, E); }
#undef GBAR
#undef ws
#undef p
#undef LAUNDER
}

extern "C" void kernel_launch(void* const* d_in, const int* in_sizes, int n_in, void* d_out, int out_size, void* d_ws, size_t ws_size, hipStream_t stream) {
    static int grid_blocks = 0;
    if (!grid_blocks) {
        int dev = 0, cus = 0, per_cu = 0;
        hipGetDevice(&dev);
        hipDeviceGetAttribute(&cus, hipDeviceAttributeMultiprocessorCount, dev);
        hipFuncSetAttribute((const void*)mega, hipFuncAttributeMaxDynamicSharedMemorySize, LDS_BYTES);
        hipOccupancyMaxActiveBlocksPerMultiprocessor(&per_cu, mega, 512, LDS_BYTES);
        if (per_cu < 1) per_cu = 1;
        grid_blocks = cus;
        if (grid_blocks > cus * per_cu) grid_blocks = cus * per_cu;
        if (ws_size < W_END) fprintf(stderr, "workspace too small: %zu < %zu\n", ws_size, (size_t)W_END);
    }
    Params p{};
    p.xp = (const float*)d_in[0]; p.xs = (const float*)d_in[1]; p.pp = (const float*)d_in[2]; p.ps = (const float*)d_in[3];
    p.state = (const float*)d_in[4]; p.ck = (const float*)d_in[5]; p.cv = (const float*)d_in[6];
    p.w_pre_mix = (const float*)d_in[7]; p.w_in = (const float*)d_in[8]; p.gate_up = (const float*)d_in[9]; p.gate_b = (const float*)d_in[10];
    p.gnw = (const float*)d_in[11]; p.sinks = (const float*)d_in[12]; p.w_out = (const float*)d_in[13]; p.w_post_mix = (const float*)d_in[14];
    p.w_pre_ffn = (const float*)d_in[15]; p.w_gate = (const float*)d_in[16]; p.w_up = (const float*)d_in[17]; p.w_down = (const float*)d_in[18];
    p.w_post_ffn = (const float*)d_in[19]; p.w_ple_gate = (const float*)d_in[20]; p.w_ple_proj = (const float*)d_in[21];
    p.out = (float*)d_out; p.ws = (unsigned char*)d_ws;
    (void)hipMemsetAsync((unsigned char*)d_ws + W_BAR, 0, 16384, stream);
    void* args[] = {&p};
    hipError_t e = hipLaunchCooperativeKernel((const void*)mega, dim3(grid_blocks), dim3(512), args, LDS_BYTES, stream);
    if (e != hipSuccess) fprintf(stderr, "cooperative launch failed: %s (grid %d)\n", hipGetErrorString(e), grid_blocks);
}
```

```cpp
#include <hip/hip_runtime.h>
#include <hip/hip_cooperative_groups.h>
#include <cstdio>
namespace cg = cooperative_groups;

#define LAS __attribute__((address_space(3)))
typedef unsigned short bf16_t;
typedef short bf16x8 __attribute__((ext_vector_type(8)));
typedef float f32x4 __attribute__((ext_vector_type(4)));
typedef unsigned u32x4 __attribute__((ext_vector_type(4)));
typedef unsigned u32x2 __attribute__((ext_vector_type(2)));

constexpr int NTOK = 33792, NPROMPT = 32768, DM = 1024, DZ = 2304, DFF = 2816;
constexpr int LDS_BYTES = 131072 + 16;
constexpr float EPS = 1e-6f;

constexpr size_t O_Y = 0, O_SGP = 34603008, O_CKP = 34668544, O_CVP = 34734080, O_SGS = 34799616, O_CKS = 36896768, O_CVS = 38993920;
constexpr size_t W_XB = 0;
constexpr size_t W_Z = 69206016;
constexpr size_t W_OM = 259522560;
constexpr size_t W_MIX = 328728576;
constexpr size_t W_PP = W_MIX + 69206016;
constexpr size_t W_PB = 467140608;
constexpr size_t W_WIN = 484442112;
constexpr size_t W_WOUT = W_WIN + 4718592;
constexpr size_t W_WGU = W_WOUT + 2097152;
constexpr size_t W_WDN = W_WGU + 11534336;
constexpr size_t W_WPG = W_WDN + 5767168;
constexpr size_t W_WPP = W_WPG + 2097152;
constexpr size_t W_RSX = W_WPP + 524288;
constexpr size_t W_SS1 = W_RSX + 135168;
constexpr size_t W_SS2 = W_SS1 + 135168;
constexpr size_t W_RSH = W_SS2 + 135168;
constexpr size_t W_LR = W_RSH + 135168;
constexpr size_t W_BAR = W_LR + 2162688;
constexpr size_t W_END = W_BAR + 16384;
constexpr size_t W_PART1 = W_Z;
constexpr size_t W_PART2 = W_OM;
constexpr size_t W_DS = W_MIX;
constexpr size_t W_EGL = W_MIX + 33554432;

struct Params {
    const float* xp; const float* xs; const float* pp; const float* ps; const float* state; const float* ck; const float* cv;
    const float* w_pre_mix; const float* w_in; const float* gate_up; const float* gate_b; const float* gnw; const float* sinks;
    const float* w_out; const float* w_post_mix; const float* w_pre_ffn; const float* w_gate; const float* w_up; const float* w_down;
    const float* w_post_ffn; const float* w_ple_gate; const float* w_ple_proj;
    float* out; unsigned char* ws;
};

__device__ __forceinline__ unsigned pk_bf16(float lo, float hi) { unsigned r; asm("v_cvt_pk_bf16_f32 %0, %1, %2" : "=v"(r) : "v"(lo), "v"(hi)); return r; }
__device__ __forceinline__ float bf_lo(unsigned u) { return __uint_as_float(u << 16); }
__device__ __forceinline__ float bf_hi(unsigned u) { return __uint_as_float(u & 0xffff0000u); }
__device__ __forceinline__ float bf2f(bf16_t b) { return __uint_as_float(((unsigned)b) << 16); }
__device__ __forceinline__ bf16_t f2bf(float f) { return (bf16_t)(pk_bf16(f, 0.f) & 0xffffu); }
__device__ __forceinline__ float sigmoidf_(float x) { return __builtin_amdgcn_rcpf(1.0f + __builtin_amdgcn_exp2f(-1.4426950408889634f * x)); }
__device__ __forceinline__ f32x4 mfma16(bf16x8 a, bf16x8 b, f32x4 c) { return __builtin_amdgcn_mfma_f32_16x16x32_bf16(a, b, c, 0, 0, 0); }
__device__ __forceinline__ bf16x8 mk8(u32x4 v) { union { u32x4 u; bf16x8 b; } x; x.u = v; return x.b; }
__device__ __forceinline__ bf16x8 mk8(u32x2 a, u32x2 b) { union { u32x4 u; bf16x8 b; } x; x.u = (u32x4){a.x, a.y, b.x, b.y}; return x.b; }


#define XB_TMO      128
#define XB_XCNT(j)  (256  + 64 * (j))
#define XB_XSUB(j)  (1280 + 64 * (j))
#define XB_XGEN(j)  (2304 + 64 * (j))
#define XB_TOP      3328
#define XB_TOPGEN   3392
#define XCD_BAR_WORDS 3456
#define XB_SPIN_CAP (1u << 18)
__device__ __forceinline__ unsigned xb_ld(unsigned* p)              { return __hip_atomic_load(p, __ATOMIC_RELAXED, __HIP_MEMORY_SCOPE_AGENT); }
__device__ __forceinline__ unsigned xb_add(unsigned* p, unsigned v) { return __hip_atomic_fetch_add(p, v, __ATOMIC_RELAXED, __HIP_MEMORY_SCOPE_AGENT); }
__device__ __forceinline__ unsigned xb_xcc_id() { return (unsigned)__builtin_amdgcn_s_getreg((3 << 11) | 20) & 0xFu; }
#define XB_SPIN(cond, bar) do { unsigned _sp = 0; while (cond) { __builtin_amdgcn_s_sleep(1); \
    if ((++_sp & 255u) == 0u) { if (xb_ld(&(bar)[XB_TMO])) break; if (_sp > XB_SPIN_CAP) { atomicAdd(&(bar)[XB_TMO], 1u); break; } } } } while (0)
struct XcdBarrier { unsigned* bar; unsigned x; volatile LAS unsigned* st; };
__device__ __forceinline__ XcdBarrier xcd_barrier_post(unsigned* bar, volatile LAS unsigned* st) {
    XcdBarrier b; b.bar = bar; b.x = xb_xcc_id(); b.st = st;
    if (threadIdx.x == 0) (void)xb_add(&bar[XB_XCNT(b.x)], 1u);
    return b;
}
__device__ __forceinline__ void xcd_barrier_complete(unsigned* bar, unsigned x, unsigned& nloc, unsigned& nx) {
    const unsigned G = gridDim.x * gridDim.y * gridDim.z;
    unsigned sum, cnt, mine, sp = 0u;
    for (;;) {
        sum = 0u; cnt = 0u; mine = 0u;
#pragma unroll
        for (unsigned j = 0; j < 16; ++j) { const unsigned c = xb_ld(&bar[XB_XCNT(j)]); sum += c; cnt += (c > 0u) ? 1u : 0u; mine = (j == x) ? c : mine; }
        if (sum == G) break;
        __builtin_amdgcn_s_sleep(1);
        if ((++sp & 255u) == 0u) { if (xb_ld(&bar[XB_TMO])) break; if (sp > XB_SPIN_CAP) { atomicAdd(&bar[XB_TMO], 1u); break; } }
    }
    nloc = mine > 0u ? mine : 1u; nx = cnt > 0u ? cnt : 1u;
}
__device__ __forceinline__ void xcd_barrier(const XcdBarrier& b) {
    asm volatile("s_waitcnt vmcnt(0)" ::: "memory");
    __syncthreads();
    if (threadIdx.x == 0) {
        unsigned* bar = b.bar;
        __builtin_amdgcn_s_waitcnt(0);
        unsigned nloc = b.st[0], nx = b.st[1];
        if (nloc == 0u) { xcd_barrier_complete(bar, b.x, nloc, nx); b.st[0] = nloc; b.st[1] = nx; }
        const unsigned old = xb_add(&bar[XB_XSUB(b.x)], 1u);
        const unsigned gen = old / nloc;
        if (old + 1u == (gen + 1u) * nloc) {
            __builtin_amdgcn_fence(__ATOMIC_RELEASE, "agent");
            asm volatile("s_waitcnt vmcnt(0)" ::: "memory");
            const unsigned og = xb_add(&bar[XB_TOP], 1u);
            const unsigned tg = og / nx;
            if (og + 1u == (tg + 1u) * nx) xb_add(&bar[XB_TOPGEN], 1u);
            else XB_SPIN(xb_ld(&bar[XB_TOPGEN]) == tg, bar);
            __builtin_amdgcn_fence(__ATOMIC_ACQUIRE, "agent");
            xb_add(&bar[XB_XGEN(b.x)], 1u);
            asm volatile("s_waitcnt vmcnt(0)" ::: "memory");
        } else {
            XB_SPIN(xb_ld(&bar[XB_XGEN(b.x)]) == gen, bar);
            __builtin_amdgcn_fence(__ATOMIC_ACQUIRE, "agent");
            asm volatile("s_waitcnt vmcnt(0)" ::: "memory");
        }
    }
    __syncthreads();
}

namespace pg8 {
constexpr int BM = 256, BK = 64, HALF = 128, HTB = HALF * BK * 2, NXCD = 8, WGM = 8;
__device__ __forceinline__ int lds_byte(int r, int c) { const int st = (r >> 4) * 2 + (c >> 5), rr = r & 15, cc = c & 31, ob = rr * 64 + cc * 2; return st * 1024 + (ob ^ (((ob >> 9) & 1) << 5)); }
__device__ __forceinline__ void stage_rc(int b, int& R, int& C) { const int st = b / 1024, sb = b % 1024, swz = sb ^ (((sb >> 9) & 1) << 5); R = (st >> 1) * 16 + swz / 64; C = (st & 1) * 32 + (swz % 64) / 2; }
__device__ __forceinline__ int perm32(int rho) { const int n = rho >> 4, i = rho & 15; return 8 * (i >> 2) + 4 * n + (i & 3); }
struct Unit { int pm, pn, k0; };
struct Gemm { const bf16_t* A; const bf16_t* Bt; int M, N, K; };
struct StaticOrder {
    int nM, nN, nwg, G, c, nt;
    __device__ void init(int M, int N, int K, int G_, int c_) { nM = M / BM; nN = N / BM; nwg = nM * nN; G = G_; c = c_; nt = K / BK; }
    __device__ bool next(int i, Unit& u) const {
        const long L = (long)i * G + c; if (L >= nwg) return false;
        int wgid = (int)L; { const int q = nwg / NXCD, r = nwg % NXCD, xcd = wgid % NXCD, off = wgid / NXCD; wgid = (xcd < r ? xcd * (q + 1) : r * (q + 1) + (xcd - r) * q) + off; }
        const int nig = WGM * nN, gid = wgid / nig, fm = gid * WGM, gsz = (nM - fm) < WGM ? (nM - fm) : WGM;
        u.pm = fm + ((wgid % nig) % gsz); u.pn = (wgid % nig) / gsz; u.k0 = 0; return true;
    }
};
struct SplitOrder {
    int pm0, nN, nsplit, nitems, G, c, nt;
    __device__ void init(int pm0_, int npm, int nN_, int nsplit_, int nt_, int G_, int c_) { pm0 = pm0_; nN = nN_; nsplit = nsplit_; nitems = npm * nN_ * nsplit_; nt = nt_; G = G_; c = c_; }
    __device__ bool next(int i, Unit& u) const {
        if (c < 0) return false;
        const long L = (long)i * G + c; if (L >= nitems) return false;
        const int l = (int)L, sp = l % nsplit, rest = l / nsplit;
        u.pn = rest % nN; u.pm = pm0 + rest / nN; u.k0 = sp * nt; return true;
    }
};

template <class Epi, class Sched>
__device__ __forceinline__ void gemm_phase(LAS unsigned char* lds, const Gemm g, const Sched& S, const Epi& E) {
    int tid = threadIdx.x; asm volatile("" : "+v"(tid));
    const int wid = __builtin_amdgcn_readfirstlane(tid >> 6), lane = tid & 63, wr = wid >> 2, wc = wid & 3, fr = lane & 15, fq = lane >> 4;
    const int K = g.K, nt = S.nt;
    unsigned voffA[2], voffB[2];
#pragma unroll
    for (int i = 0; i < 2; ++i) { int R, C; stage_rc(tid * 16 + i * 8192, R, C); const int Rb = Epi::PERM ? ((R & ~31) + perm32(R & 31)) : R;
        voffA[i] = (unsigned)(R * K + C) * 2u; voffB[i] = (unsigned)(Rb * K + C) * 2u; }
    const size_t kstep = (size_t)(BK * 2);
    const size_t hstep = (size_t)HALF * K * 2;
    const size_t tstep = 2 * hstep;
    const unsigned ldsw = (unsigned)wid * 1024u;
    const int aoff = lds_byte(wr * 64 + fr, fq * 8), boff = lds_byte(wc * 32 + fr, fq * 8);
#define PG8_SA(b, h) (((b) * 2 + (h)) * HTB)
#define PG8_SB(b, h) ((4 + (b) * 2 + (h)) * HTB)
#define PG8_STAGE(bufoff, gbase, voff) do { _Pragma("unroll") for (int _i = 0; _i < 2; ++_i) \
        __builtin_amdgcn_global_load_lds((const unsigned*)((const char*)(gbase) + (voff)[_i]), (LAS unsigned*)(lds + (bufoff) + ldsw + _i * 8192), 16, 0, 0); } while (0)
#define PG8_LDA(dst, b, h) do { _Pragma("unroll") for (int m = 0; m < 4; ++m) _Pragma("unroll") for (int k = 0; k < 2; ++k) dst[m][k] = *(const LAS bf16x8*)(lds + PG8_SA(b, h) + aoff + m * 2048 + k * 1024); } while (0)
#define PG8_LDB(dst, b, h) do { _Pragma("unroll") for (int n = 0; n < 2; ++n) _Pragma("unroll") for (int k = 0; k < 2; ++k) dst[n][k] = *(const LAS bf16x8*)(lds + PG8_SB(b, h) + boff + n * 2048 + k * 1024); } while (0)
#define PG8_MMA(ai, bj, At, Bt) do { __builtin_amdgcn_s_setprio(1); _Pragma("unroll") for (int m = 0; m < 4; ++m) _Pragma("unroll") for (int n = 0; n < 2; ++n) _Pragma("unroll") for (int k = 0; k < 2; ++k) \
        acc[ai][bj][m][n] = __builtin_amdgcn_mfma_f32_16x16x32_bf16(Bt[n][k], At[m][k], acc[ai][bj][m][n], 0, 0, 0); __builtin_amdgcn_s_setprio(0); } while (0)
#define PG8_WAIT_V(n) asm volatile("s_waitcnt vmcnt(" #n ")" ::: "memory")
#define PG8_WAIT_L(n) asm volatile("s_waitcnt lgkmcnt(" #n ")" ::: "memory")
#define PG8_BAR __builtin_amdgcn_s_barrier()
#define PG8_SCHED __builtin_amdgcn_sched_barrier(0)
    Unit cur, nxt; int ui = 0;
    if (!S.next(0, cur)) return;
    f32x4 acc[2][2][4][2];
#pragma unroll
    for (int a = 0; a < 2; ++a)
#pragma unroll
        for (int b = 0; b < 2; ++b)
#pragma unroll
            for (int m = 0; m < 4; ++m)
#pragma unroll
                for (int n = 0; n < 2; ++n) acc[a][b][m][n] = (f32x4){0.f, 0.f, 0.f, 0.f};
    bf16x8 At[4][2], B0[2][2], B1[2][2];
    const char* cA = (const char*)g.A + (size_t)cur.pm * tstep + (size_t)cur.k0 * kstep; const char* cB = (const char*)g.Bt + (size_t)cur.pn * tstep + (size_t)cur.k0 * kstep;
    PG8_STAGE(PG8_SB(0, 0), cB, voffB); PG8_STAGE(PG8_SA(0, 0), cA, voffA); PG8_STAGE(PG8_SB(0, 1), cB + hstep, voffB); PG8_STAGE(PG8_SA(0, 1), cA + hstep, voffA);
    if (wr == 1) PG8_BAR;
    PG8_WAIT_V(4); PG8_BAR;
    PG8_STAGE(PG8_SB(1, 0), cB + kstep, voffB); PG8_STAGE(PG8_SA(1, 0), cA + kstep, voffA); PG8_STAGE(PG8_SB(1, 1), cB + hstep + kstep, voffB);
    PG8_WAIT_V(6); PG8_BAR;
    for (;;) {
        const bool has_next = S.next(ui + 1, nxt);
        const char* nA = has_next ? (const char*)g.A + (size_t)nxt.pm * tstep + (size_t)nxt.k0 * kstep : cA; const char* nB = has_next ? (const char*)g.Bt + (size_t)nxt.pn * tstep + (size_t)nxt.k0 * kstep : cB;
        for (int t = 0; t < nt; t += 2) {
            const bool last = (t == nt - 2);
            const char* a1 = cA + (size_t)(t + 1) * kstep;
            const char* a2 = last ? nA : cA + (size_t)(t + 2) * kstep; const char* b2 = last ? nB : cB + (size_t)(t + 2) * kstep;
            const char* a3 = a2 + kstep; const char* b3 = b2 + kstep;
            PG8_LDB(B0, 0, 0); PG8_SCHED; PG8_LDA(At, 0, 0); PG8_STAGE(PG8_SA(1, 1), a1 + hstep, voffA);
            PG8_WAIT_L(8); PG8_BAR; PG8_WAIT_L(0); PG8_MMA(0, 0, At, B0); PG8_BAR; PG8_SCHED;
            PG8_LDB(B1, 0, 1); PG8_STAGE(PG8_SB(0, 0), b2, voffB);
            PG8_BAR; PG8_WAIT_L(0); PG8_MMA(0, 1, At, B1); PG8_BAR;
            PG8_LDA(At, 0, 1); PG8_STAGE(PG8_SA(0, 0), a2, voffA);
            PG8_BAR; PG8_WAIT_L(0); PG8_MMA(1, 0, At, B0); PG8_BAR; PG8_SCHED;
            PG8_STAGE(PG8_SB(0, 1), b2 + hstep, voffB);
            PG8_WAIT_V(6); PG8_BAR; PG8_MMA(1, 1, At, B1); PG8_BAR;
            PG8_LDB(B0, 1, 0); PG8_SCHED; PG8_LDA(At, 1, 0); PG8_STAGE(PG8_SA(0, 1), a2 + hstep, voffA);
            PG8_WAIT_L(8); PG8_BAR; PG8_WAIT_L(0); PG8_MMA(0, 0, At, B0); PG8_BAR; PG8_SCHED;
            PG8_LDB(B1, 1, 1); PG8_STAGE(PG8_SB(1, 0), b3, voffB);
            PG8_BAR; PG8_WAIT_L(0); PG8_MMA(0, 1, At, B1); PG8_BAR;
            PG8_LDA(At, 1, 1); PG8_STAGE(PG8_SA(1, 0), a3, voffA);
            PG8_BAR; PG8_WAIT_L(0); PG8_MMA(1, 0, At, B0); PG8_BAR; PG8_SCHED;
            PG8_STAGE(PG8_SB(1, 1), b3 + hstep, voffB);
            PG8_WAIT_V(6); PG8_BAR; PG8_MMA(1, 1, At, B1); PG8_BAR;
        }
        E(acc, cur, wr, wc, fr, fq);
        if (!has_next) break;
#pragma unroll
        for (int a = 0; a < 2; ++a)
#pragma unroll
            for (int b = 0; b < 2; ++b)
#pragma unroll
                for (int m = 0; m < 4; ++m)
#pragma unroll
                    for (int n = 0; n < 2; ++n) acc[a][b][m][n] = (f32x4){0.f, 0.f, 0.f, 0.f};
        cur = nxt; cA = nA; cB = nB; ++ui;
    }
    PG8_WAIT_V(0);
    if (wr == 0) PG8_BAR;
    PG8_BAR;
#undef PG8_SA
#undef PG8_SB
#undef PG8_STAGE
#undef PG8_LDA
#undef PG8_LDB
#undef PG8_MMA
#undef PG8_WAIT_V
#undef PG8_WAIT_L
#undef PG8_BAR
#undef PG8_SCHED
}
}

struct EpiBf16Scale {
    static constexpr bool PERM = true;
    bf16_t* O; int ldc; const float* rs;
    __device__ __forceinline__ void operator()(const f32x4 (&acc)[2][2][4][2], const pg8::Unit& u, int wr, int wc, int fr, int fq) const {
        const int row0 = u.pm * 256 + wr * 64 + fr, col0 = u.pn * 256 + wc * 32 + 8 * fq;
#pragma unroll
        for (int ai = 0; ai < 2; ++ai)
#pragma unroll
            for (int m = 0; m < 4; ++m) {
                const int row = row0 + ai * 128 + m * 16; const float s = rs ? rs[row] : 1.0f;
                bf16_t* rowp = O + (size_t)row * ldc + col0;
#pragma unroll
                for (int bj = 0; bj < 2; ++bj) { const f32x4 v0 = acc[ai][bj][m][0] * s, v1 = acc[ai][bj][m][1] * s;
                    u32x4 w; w.x = pk_bf16(v0[0], v0[1]); w.y = pk_bf16(v0[2], v0[3]); w.z = pk_bf16(v1[0], v1[1]); w.w = pk_bf16(v1[2], v1[3]);
                    *(u32x4*)(rowp + bj * 128) = w; }
            }
    }
};
struct EpiF32Part {
    static constexpr bool PERM = false;
    float* P; int row_base; int nt;
    __device__ __forceinline__ void operator()(const f32x4 (&acc)[2][2][4][2], const pg8::Unit& u, int wr, int wc, int fr, int fq) const {
        const int row0 = u.pm * 256 + wr * 64 + fr - row_base, col0 = u.pn * 256 + wc * 32 + 4 * fq;
        float* base = P + (size_t)(u.k0 / nt) * 1048576;
#pragma unroll
        for (int ai = 0; ai < 2; ++ai)
#pragma unroll
            for (int m = 0; m < 4; ++m) {
                float* rowp = base + (size_t)(row0 + ai * 128 + m * 16) * DM + col0;
#pragma unroll
                for (int bj = 0; bj < 2; ++bj)
#pragma unroll
                    for (int n = 0; n < 2; ++n) *(f32x4*)(rowp + bj * 128 + n * 16) = acc[ai][bj][m][n];
            }
    }
};
struct EpiAct {
    static constexpr bool PERM = true;
    bf16_t* O; const float* rs;
    __device__ __forceinline__ void operator()(const f32x4 (&acc)[2][2][4][2], const pg8::Unit& u, int wr, int wc, int fr, int fq) const {
        const int row0 = u.pm * 256 + wr * 64 + fr, col0 = u.pn * 128 + wc * 32 + 8 * fq;
#pragma unroll
        for (int ai = 0; ai < 2; ++ai)
#pragma unroll
            for (int m = 0; m < 4; ++m) {
                const int row = row0 + ai * 128 + m * 16; const float s = rs[row];
                float a[8];
#pragma unroll
                for (int n = 0; n < 2; ++n)
#pragma unroll
                    for (int j = 0; j < 4; ++j) { const float gv = acc[ai][0][m][n][j] * s, uv = acc[ai][1][m][n][j] * s; a[n * 4 + j] = gv * sigmoidf_(gv) * uv; }
                u32x4 w; w.x = pk_bf16(a[0], a[1]); w.y = pk_bf16(a[2], a[3]); w.z = pk_bf16(a[4], a[5]); w.w = pk_bf16(a[6], a[7]);
                *(u32x4*)(O + (size_t)row * DFF + col0) = w;
            }
    }
};
struct EpiOut {
    static constexpr bool PERM = false;
    float* Y; const bf16_t* PP; const bf16_t* H2;
    __device__ __forceinline__ void operator()(const f32x4 (&acc)[2][2][4][2], const pg8::Unit& u, int wr, int wc, int fr, int fq) const {
        const int row0 = u.pm * 256 + wr * 64 + fr, col0 = u.pn * 256 + wc * 32 + 4 * fq;
#pragma unroll
        for (int ai = 0; ai < 2; ++ai)
#pragma unroll
            for (int m = 0; m < 4; ++m) {
                const int row = row0 + ai * 128 + m * 16; float* rowp = Y + (size_t)row * DM + col0; const bf16_t* pr = PP + (size_t)row * DM + col0; const bf16_t* hr = H2 + (size_t)row * DM + col0;
#pragma unroll
                for (int bj = 0; bj < 2; ++bj)
#pragma unroll
                    for (int n = 0; n < 2; ++n) { const f32x4 v = acc[ai][bj][m][n]; const u32x2 hq = *(const u32x2*)(hr + bj * 128 + n * 16); f32x4 h = (f32x4){bf_lo(hq.x), bf_hi(hq.x), bf_lo(hq.y), bf_hi(hq.y)}; const u32x2 pq = *(const u32x2*)(pr + bj * 128 + n * 16);
                        h[0] += sigmoidf_(v[0]) * bf_lo(pq.x); h[1] += sigmoidf_(v[1]) * bf_hi(pq.x); h[2] += sigmoidf_(v[2]) * bf_lo(pq.y); h[3] += sigmoidf_(v[3]) * bf_hi(pq.y);
                        *(f32x4*)(rowp + bj * 128 + n * 16) = h; }
            }
    }
};

template <class CM, class RM>
__device__ __forceinline__ void prep_weight(bf16_t* dst, const float* src, int ld_src, int Kdim, int Ncount, const float* scale, CM cm, RM rm, int gtid, int gthreads) {
    const int k8n = Kdim >> 3; const long total = (long)Ncount * k8n;
    for (long idx = gtid; idx < total; idx += gthreads) {
        const int n = (int)(idx % Ncount); const int k0 = (int)(idx / Ncount) * 8; const int sc = cm(n); const int dr = rm(n);
        float v[8];
#pragma unroll
        for (int j = 0; j < 8; ++j) { float x = src[(size_t)(k0 + j) * ld_src + sc]; if (scale) x *= scale[k0 + j]; v[j] = x; }
        u32x4 w; w.x = pk_bf16(v[0], v[1]); w.y = pk_bf16(v[2], v[3]); w.z = pk_bf16(v[4], v[5]); w.w = pk_bf16(v[6], v[7]);
        *(u32x4*)(dst + (size_t)dr * Kdim + k0) = w;
    }
}

__device__ __forceinline__ void phase_prep(const Params& p, LAS unsigned char* lds) {
    int tid = threadIdx.x; asm volatile("" : "+v"(tid));
    const int lane = tid & 63, wid = tid >> 6;
    const int gtid = blockIdx.x * 512 + tid, gthreads = gridDim.x * 512;
    unsigned char* ws = p.ws;
    auto idn = [](int n) { return n; };
    prep_weight((bf16_t*)(ws + W_WIN), p.w_in, 2320, 1024, 2304, p.w_pre_mix, [](int n) { return n < 1536 ? n : n + 16; }, idn, gtid, gthreads);
    prep_weight((bf16_t*)(ws + W_WOUT), p.w_out, 1024, 1024, 1024, (const float*)nullptr, idn, idn, gtid, gthreads);
    prep_weight((bf16_t*)(ws + W_WGU), p.w_gate, 2816, 1024, 2816, p.w_pre_ffn, idn, [](int n) { return (n >> 7) * 256 + (n & 127); }, gtid, gthreads);
    prep_weight((bf16_t*)(ws + W_WGU), p.w_up, 2816, 1024, 2816, p.w_pre_ffn, idn, [](int n) { return (n >> 7) * 256 + 128 + (n & 127); }, gtid, gthreads);
    prep_weight((bf16_t*)(ws + W_WDN), p.w_down, 1024, 2816, 1024, (const float*)nullptr, idn, idn, gtid, gthreads);
    prep_weight((bf16_t*)(ws + W_WPG), p.w_ple_gate, 1024, 1024, 1024, (const float*)nullptr, idn, idn, gtid, gthreads);
    prep_weight((bf16_t*)(ws + W_WPP), p.w_ple_proj, 1024, 256, 1024, (const float*)nullptr, idn, idn, gtid, gthreads);
    {
        bf16_t* pb = (bf16_t*)(ws + W_PB);
        const long total8 = (long)NTOK * 256 / 8, np8 = (long)NPROMPT * 256 / 8;
        for (long i = gtid; i < total8; i += gthreads) {
            const float* s = i < np8 ? p.pp + i * 8 : p.ps + (i - np8) * 8;
            const f32x4 a = *(const f32x4*)s, b = *(const f32x4*)(s + 4);
            u32x4 w; w.x = pk_bf16(a[0], a[1]); w.y = pk_bf16(a[2], a[3]); w.z = pk_bf16(b[0], b[1]); w.w = pk_bf16(b[2], b[3]);
            *(u32x4*)(pb + i * 8) = w;
        }
    }
    LAS float* wl = (LAS float*)lds;
    for (int idx = tid; idx < 16384; idx += 512) { const int k = idx >> 4, j = idx & 15; wl[j * 1024 + k] = p.w_pre_mix[k] * p.w_in[(size_t)k * 2320 + 1536 + j]; }
    __syncthreads();
    bf16_t* xb = (bf16_t*)(ws + W_XB); float* rsx = (float*)(ws + W_RSX); float* lr = (float*)(ws + W_LR);
    const int gw = blockIdx.x * 8 + wid, nw = gridDim.x * 8;
    for (int row = gw; row < NTOK; row += nw) {
        const float* xr = row < NPROMPT ? p.xp + (size_t)row * DM : p.xs + (size_t)(row - NPROMPT) * DM;
        f32x4 x[4]; float acc[16]; float s = 0.f;
#pragma unroll
        for (int i = 0; i < 4; ++i) x[i] = *(const f32x4*)(xr + i * 256 + lane * 4);
#pragma unroll
        for (int j = 0; j < 16; ++j) acc[j] = 0.f;
#pragma unroll
        for (int i = 0; i < 4; ++i) {
            const f32x4 v = x[i];
            s += v[0] * v[0] + v[1] * v[1] + v[2] * v[2] + v[3] * v[3];
            u32x2 w; w.x = pk_bf16(v[0], v[1]); w.y = pk_bf16(v[2], v[3]); *(u32x2*)(xb + (size_t)row * DM + i * 256 + lane * 4) = w;
#pragma unroll
            for (int j = 0; j < 16; ++j) { const f32x4 w4 = *(const LAS f32x4*)(wl + j * 1024 + i * 256 + lane * 4); acc[j] += v[0] * w4[0] + v[1] * w4[1] + v[2] * w4[2] + v[3] * w4[3]; }
            __builtin_amdgcn_sched_barrier(0);
        }
#pragma unroll
        for (int o = 1; o < 64; o <<= 1) s += __shfl_xor(s, o);
        const float rstd = rsqrtf(s * (1.0f / 1024.0f) + EPS);
        float a8[8], a4[4], a2[2], a1;
        const bool b5 = lane & 32, b4 = lane & 16, b3 = lane & 8, b2 = lane & 4;
#pragma unroll
        for (int j = 0; j < 8; ++j) { const float keep = b5 ? acc[j + 8] : acc[j], send = b5 ? acc[j] : acc[j + 8]; a8[j] = keep + __shfl_xor(send, 32); }
#pragma unroll
        for (int j = 0; j < 4; ++j) { const float keep = b4 ? a8[j + 4] : a8[j], send = b4 ? a8[j] : a8[j + 4]; a4[j] = keep + __shfl_xor(send, 16); }
#pragma unroll
        for (int j = 0; j < 2; ++j) { const float keep = b3 ? a4[j + 2] : a4[j], send = b3 ? a4[j] : a4[j + 2]; a2[j] = keep + __shfl_xor(send, 8); }
        { const float keep = b2 ? a2[1] : a2[0], send = b2 ? a2[0] : a2[1]; a1 = keep + __shfl_xor(send, 4); }
        a1 += __shfl_xor(a1, 1); a1 += __shfl_xor(a1, 2);
        const int jidx = (b5 ? 8 : 0) + (b4 ? 4 : 0) + (b3 ? 2 : 0) + (b2 ? 1 : 0);
        if ((lane & 3) == 0) lr[(size_t)row * 16 + jidx] = a1 * rstd;
        if (lane == 0) rsx[row] = rstd;
    }
    __syncthreads();
}

template <bool SAMPLE>
__device__ __forceinline__ void swa_item(const Params& p, LAS unsigned char* lds, int item) {
    constexpr int NQT = SAMPLE ? 1 : 2;
    int tid = threadIdx.x; asm volatile("" : "+v"(tid));
    const int lane = tid & 63, wid = __builtin_amdgcn_readfirstlane(tid >> 6), fr = lane & 15, fq = lane >> 4;
    const bf16_t* z = (const bf16_t*)(p.ws + W_Z); bf16_t* om = (bf16_t*)(p.ws + W_OM);
    int b, q0;
    if (SAMPLE) { b = item; q0 = 0; } else { b = item >> 8; q0 = (item & 255) * 32; }
    LAS unsigned char* Kl = lds; LAS unsigned char* Vl = lds + 46080;
#pragma unroll
    for (int idx0 = 0; idx0 < 2560; idx0 += 512) {
        const int idx = idx0 + tid;
        const int kv = idx / 1280, rem = idx % 1280, kk = rem >> 3, ch = rem & 7;
        u32x4 kc = (u32x4){0u, 0u, 0u, 0u}, vc = (u32x4){0u, 0u, 0u, 0u};
        if (SAMPLE) {
            if (kk < 128) {
                const float* ks = p.ck + ((size_t)(b * 128 + kk) * 2 + kv) * 64 + ch * 8; const float* vs = p.cv + ((size_t)(b * 128 + kk) * 2 + kv) * 64 + ch * 8;
                const f32x4 a = *(const f32x4*)ks, c = *(const f32x4*)(ks + 4), d = *(const f32x4*)vs, e = *(const f32x4*)(vs + 4);
                kc = (u32x4){pk_bf16(a[0], a[1]), pk_bf16(a[2], a[3]), pk_bf16(c[0], c[1]), pk_bf16(c[2], c[3])};
                vc = (u32x4){pk_bf16(d[0], d[1]), pk_bf16(d[2], d[3]), pk_bf16(e[0], e[1]), pk_bf16(e[2], e[3])};
            } else if (kk < 136) {
                const bf16_t* zr = z + (size_t)(NPROMPT + b * 8 + kk - 128) * DZ;
                kc = *(const u32x4*)(zr + 2048 + kv * 64 + ch * 8); vc = *(const u32x4*)(zr + 2176 + kv * 64 + ch * 8);
            }
        } else {
            const int t = q0 - 128 + kk;
            if (t >= 0) { const bf16_t* zr = z + (size_t)(b * 8192 + t) * DZ; kc = *(const u32x4*)(zr + 2048 + kv * 64 + ch * 8); vc = *(const u32x4*)(zr + 2176 + kv * 64 + ch * 8); }
        }
        *(LAS u32x4*)(Kl + (kv * 160 + kk) * 144 + ch * 16) = kc;
        LAS bf16_t* vt = (LAS bf16_t*)Vl + (size_t)(kv * 64 + ch * 8) * 168 + kk;
        vt[0 * 168] = (bf16_t)(vc.x & 0xffffu); vt[1 * 168] = (bf16_t)(vc.x >> 16); vt[2 * 168] = (bf16_t)(vc.y & 0xffffu); vt[3 * 168] = (bf16_t)(vc.y >> 16);
        vt[4 * 168] = (bf16_t)(vc.z & 0xffffu); vt[5 * 168] = (bf16_t)(vc.z >> 16); vt[6 * 168] = (bf16_t)(vc.w & 0xffffu); vt[7 * 168] = (bf16_t)(vc.w >> 16);
    }
    __syncthreads();
    {
        const int h = wid, kv = h >> 2;
        const float slope = exp2f(-(float)(h + 1)); const float sink = p.sinks[h];
#pragma unroll 1
        for (int qt = 0; qt < NQT; ++qt) {
            bf16x8 qf[2]; size_t qrow; bool qok;
            if (SAMPLE) { qok = fr < 8; qrow = (size_t)(NPROMPT + b * 8 + (fr & 7)); } else { qok = true; qrow = (size_t)(b * 8192 + q0 + qt * 16 + fr); }
#pragma unroll
            for (int ds = 0; ds < 2; ++ds) { u32x4 v = *(const u32x4*)(z + qrow * DZ + 1536 + h * 64 + ds * 32 + fq * 8); if (!qok) v = (u32x4){0u, 0u, 0u, 0u}; qf[ds] = mk8(v); }
            f32x4 s[10];
            float mx = sink;
            const int qi = qt * 16 + fr;
#pragma unroll
            for (int kt = 0; kt < 10; ++kt) {
                const bf16x8 k0 = *(const LAS bf16x8*)(Kl + (kv * 160 + kt * 16 + fr) * 144 + fq * 16);
                const bf16x8 k1 = *(const LAS bf16x8*)(Kl + (kv * 160 + kt * 16 + fr) * 144 + 64 + fq * 16);
                f32x4 c = (f32x4){0.f, 0.f, 0.f, 0.f};
                c = mfma16(k0, qf[0], c); c = mfma16(k1, qf[1], c);
#pragma unroll
                for (int r = 0; r < 4; ++r) {
                    const int kk = kt * 16 + fq * 4 + r;
                    const bool valid = (kk > qi) && (kk <= 128 + qi) && (SAMPLE || (q0 - 128 + kk >= 0));
                    const float sv = valid ? c[r] * 0.125f - slope * (float)(128 + qi - kk) : -1e30f;
                    c[r] = sv; mx = fmaxf(mx, sv);
                }
                s[kt] = c;
            }
            float m = mx; m = fmaxf(m, __shfl_xor(m, 16)); m = fmaxf(m, __shfl_xor(m, 32));
            float sum = 0.f;
#pragma unroll
            for (int kt = 0; kt < 10; ++kt)
#pragma unroll
                for (int r = 0; r < 4; ++r) { const float e = __expf(s[kt][r] - m); s[kt][r] = e; sum += e; }
            sum += __shfl_xor(sum, 16); sum += __shfl_xor(sum, 32);
            const float den = sum + __expf(sink - m);
            f32x4 o[4];
#pragma unroll
            for (int ct = 0; ct < 4; ++ct) o[ct] = (f32x4){0.f, 0.f, 0.f, 0.f};
#pragma unroll
            for (int ks = 0; ks < 5; ++ks) {
                const f32x4 a = s[2 * ks], c = s[2 * ks + 1];
                const bf16x8 pf = mk8((u32x4){pk_bf16(a[0], a[1]), pk_bf16(a[2], a[3]), pk_bf16(c[0], c[1]), pk_bf16(c[2], c[3])});
#pragma unroll
                for (int ct = 0; ct < 4; ++ct) {
                    const LAS unsigned char* vp = Vl + ((kv * 64 + ct * 16 + fr) * 168 + ks * 32 + fq * 4) * 2;
                    const u32x2 va = *(const LAS u32x2*)vp, vb = *(const LAS u32x2*)(vp + 32);
                    o[ct] = mfma16(mk8(va, vb), pf, o[ct]);
                }
            }
            const float inv = 1.0f / den;
            if (qok) {
#pragma unroll
                for (int ct = 0; ct < 4; ++ct) { const f32x4 v = o[ct] * inv; u32x2 w; w.x = pk_bf16(v[0], v[1]); w.y = pk_bf16(v[2], v[3]);
                    *(u32x2*)(om + qrow * DM + 512 + h * 64 + ct * 16 + fq * 4) = w; }
            }
        }
    }
    __syncthreads();
}

template <bool G3>
__device__ __forceinline__ void gla_prompt_item(const Params& p, LAS unsigned char* lds, int item) {
    int tid = threadIdx.x; asm volatile("" : "+v"(tid));
    const int lane = tid & 63, wid = __builtin_amdgcn_readfirstlane(tid >> 6), fr = lane & 15, fq = lane >> 4;
    const int hl = wid >> 1, pw = wid & 1;
    const int hq = item & 1, n = (item >> 1) & 127, b = item >> 8;
    const int h = hq * 4 + hl;
    const int row0 = b * 8192 + n * 64;
    const bf16_t* z = (const bf16_t*)(p.ws + W_Z); bf16_t* om = (bf16_t*)(p.ws + W_OM);
    float* dS = (float*)(p.ws + W_DS); float* egl = (float*)(p.ws + W_EGL);
    const float* lr = (const float*)(p.ws + W_LR);
    LAS unsigned char* hb = lds + hl * 24576;
    LAS unsigned char* QT = hb; LAS unsigned char* KT = hb + 5120; LAS unsigned char* VT = hb + 10240; LAS unsigned char* ST = hb + 19456;
    const size_t ch_idx = (size_t)(b * 128 + n) * 8 + h;
    float G[16], Gl[16];
    {
        const float* lrp = lr + (size_t)(row0 + lane) * 16;
        const f32x4 l0 = *(const f32x4*)lrp, l1 = *(const f32x4*)(lrp + 4), l2 = *(const f32x4*)(lrp + 8), l3 = *(const f32x4*)(lrp + 12);
        const float lv[16] = {l0[0], l0[1], l0[2], l0[3], l1[0], l1[1], l1[2], l1[3], l2[0], l2[1], l2[2], l2[3], l3[0], l3[1], l3[2], l3[3]};
        const int cb = h * 32 + pw * 16;
#pragma unroll
        for (int dd = 0; dd < 16; ++dd) {
            float x = p.gate_b[cb + dd];
#pragma unroll
            for (int r = 0; r < 16; ++r) x += lv[r] * p.gate_up[r * 256 + cb + dd];
            float v = (fminf(x, 0.f) - __logf(1.0f + __expf(-fabsf(x)))) * (1.0f / 16.0f);
#pragma unroll
            for (int o = 1; o < 64; o <<= 1) { const float t = __shfl_up(v, o); if (lane >= o) v += t; }
            G[dd] = v; Gl[dd] = __shfl(v, 63);
        }
    }
    const bf16_t* zr = z + (size_t)(row0 + lane) * DZ;
    if (G3) {
        const u32x4 qa = *(const u32x4*)(zr + h * 32 + pw * 16), qb = *(const u32x4*)(zr + h * 32 + pw * 16 + 8);
        const u32x4 ka = *(const u32x4*)(zr + 256 + h * 32 + pw * 16), kb = *(const u32x4*)(zr + 256 + h * 32 + pw * 16 + 8);
        const unsigned qu[8] = {qa.x, qa.y, qa.z, qa.w, qb.x, qb.y, qb.z, qb.w}, ku[8] = {ka.x, ka.y, ka.z, ka.w, kb.x, kb.y, kb.z, kb.w};
        unsigned qo[8], ko[8];
        const float scale = 0.17677669529663687f;
#pragma unroll
        for (int i = 0; i < 8; ++i) {
            const float e0 = __expf(G[2 * i]), e1 = __expf(G[2 * i + 1]);
            qo[i] = pk_bf16(bf_lo(qu[i]) * scale * e0, bf_hi(qu[i]) * scale * e1);
            ko[i] = pk_bf16(bf_lo(ku[i]) * __expf(-G[2 * i]), bf_hi(ku[i]) * __expf(-G[2 * i + 1]));
        }
        *(LAS u32x4*)(QT + lane * 80 + pw * 32) = (u32x4){qo[0], qo[1], qo[2], qo[3]}; *(LAS u32x4*)(QT + lane * 80 + pw * 32 + 16) = (u32x4){qo[4], qo[5], qo[6], qo[7]};
        *(LAS u32x4*)(KT + lane * 80 + pw * 32) = (u32x4){ko[0], ko[1], ko[2], ko[3]}; *(LAS u32x4*)(KT + lane * 80 + pw * 32 + 16) = (u32x4){ko[4], ko[5], ko[6], ko[7]};
        const float* sp = dS + ch_idx * 2048 + (size_t)(pw * 16) * 64 + lane;
        unsigned so[8];
#pragma unroll
        for (int i = 0; i < 8; ++i) so[i] = pk_bf16(sp[(2 * i) * 64], sp[(2 * i + 1) * 64]);
        *(LAS u32x4*)(ST + lane * 80 + pw * 32) = (u32x4){so[0], so[1], so[2], so[3]}; *(LAS u32x4*)(ST + lane * 80 + pw * 32 + 16) = (u32x4){so[4], so[5], so[6], so[7]};
    } else {
        const u32x4 ka = *(const u32x4*)(zr + 256 + h * 32 + pw * 16), kb = *(const u32x4*)(zr + 256 + h * 32 + pw * 16 + 8);
        const unsigned ku[8] = {ka.x, ka.y, ka.z, ka.w, kb.x, kb.y, kb.z, kb.w};
#pragma unroll
        for (int i = 0; i < 8; ++i) {
            const float k0 = bf_lo(ku[i]) * __expf(Gl[2 * i] - G[2 * i]), k1 = bf_hi(ku[i]) * __expf(Gl[2 * i + 1] - G[2 * i + 1]);
            const unsigned pk = pk_bf16(k0, k1);
            *(LAS bf16_t*)(KT + (pw * 16 + 2 * i) * 144 + lane * 2) = (bf16_t)(pk & 0xffffu);
            *(LAS bf16_t*)(KT + (pw * 16 + 2 * i + 1) * 144 + lane * 2) = (bf16_t)(pk >> 16);
        }
    }
    {
        const bf16_t* vr = zr + 512 + h * 64 + pw * 32;
#pragma unroll
        for (int q4 = 0; q4 < 4; ++q4) {
            const u32x4 v = *(const u32x4*)(vr + q4 * 8);
            LAS unsigned char* vt = VT + (pw * 32 + q4 * 8) * 144 + lane * 2;
            *(LAS bf16_t*)(vt + 0 * 144) = (bf16_t)(v.x & 0xffffu); *(LAS bf16_t*)(vt + 1 * 144) = (bf16_t)(v.x >> 16);
            *(LAS bf16_t*)(vt + 2 * 144) = (bf16_t)(v.y & 0xffffu); *(LAS bf16_t*)(vt + 3 * 144) = (bf16_t)(v.y >> 16);
            *(LAS bf16_t*)(vt + 4 * 144) = (bf16_t)(v.z & 0xffffu); *(LAS bf16_t*)(vt + 5 * 144) = (bf16_t)(v.z >> 16);
            *(LAS bf16_t*)(vt + 6 * 144) = (bf16_t)(v.w & 0xffffu); *(LAS bf16_t*)(vt + 7 * 144) = (bf16_t)(v.w >> 16);
        }
    }
    __syncthreads();
    if (!G3) {
#pragma unroll
        for (int ct = 0; ct < 4; ++ct) {
            f32x4 acc = (f32x4){0.f, 0.f, 0.f, 0.f};
#pragma unroll
            for (int s = 0; s < 2; ++s) {
                const bf16x8 a = *(const LAS bf16x8*)(VT + (ct * 16 + fr) * 144 + (s * 32 + fq * 8) * 2);
                const bf16x8 bb = *(const LAS bf16x8*)(KT + (pw * 16 + fr) * 144 + (s * 32 + fq * 8) * 2);
                acc = mfma16(a, bb, acc);
            }
            *(f32x4*)(dS + ch_idx * 2048 + (size_t)(pw * 16 + fr) * 64 + ct * 16 + fq * 4) = acc;
        }
        float e = 0.f;
#pragma unroll
        for (int dd = 0; dd < 16; ++dd) e = (lane == dd) ? Gl[dd] : e;
        if (lane < 16) egl[ch_idx * 32 + pw * 16 + lane] = __expf(e);
    } else {
        const float* gnw = p.gnw;
#pragma unroll 1
        for (int ii = 0; ii < 2; ++ii) {
            const int it = ii == 0 ? pw : 3 - pw;
            const bf16x8 qf = *(const LAS bf16x8*)(QT + (it * 16 + fr) * 80 + fq * 16);
            f32x4 o[4];
#pragma unroll
            for (int ct = 0; ct < 4; ++ct) o[ct] = (f32x4){0.f, 0.f, 0.f, 0.f};
            const int nks = (it >> 1) + 1;
            const int i = it * 16 + fr;
#pragma unroll 1
            for (int s = 0; s < nks; ++s) {
                const bf16x8 k0 = *(const LAS bf16x8*)(KT + (s * 32 + fr) * 80 + fq * 16), k1 = *(const LAS bf16x8*)(KT + (s * 32 + 16 + fr) * 80 + fq * 16);
                f32x4 c0 = mfma16(k0, qf, (f32x4){0.f, 0.f, 0.f, 0.f}), c1 = mfma16(k1, qf, (f32x4){0.f, 0.f, 0.f, 0.f});
#pragma unroll
                for (int r = 0; r < 4; ++r) { const int j0 = s * 32 + fq * 4 + r; if (j0 > i) c0[r] = 0.f; if (j0 + 16 > i) c1[r] = 0.f; }
                const bf16x8 pf = mk8((u32x4){pk_bf16(c0[0], c0[1]), pk_bf16(c0[2], c0[3]), pk_bf16(c1[0], c1[1]), pk_bf16(c1[2], c1[3])});
#pragma unroll
                for (int ct = 0; ct < 4; ++ct) {
                    const LAS unsigned char* vp = VT + (ct * 16 + fr) * 144 + (s * 32 + fq * 4) * 2;
                    const u32x2 va = *(const LAS u32x2*)vp, vb = *(const LAS u32x2*)(vp + 32);
                    o[ct] = mfma16(mk8(va, vb), pf, o[ct]);
                }
            }
#pragma unroll
            for (int ct = 0; ct < 4; ++ct) { const bf16x8 sf = *(const LAS bf16x8*)(ST + (ct * 16 + fr) * 80 + fq * 16); o[ct] = mfma16(sf, qf, o[ct]); }
            float ss = 0.f;
#pragma unroll
            for (int ct = 0; ct < 4; ++ct) ss += o[ct][0] * o[ct][0] + o[ct][1] * o[ct][1] + o[ct][2] * o[ct][2] + o[ct][3] * o[ct][3];
            ss += __shfl_xor(ss, 16); ss += __shfl_xor(ss, 32);
            const float rstd = rsqrtf(ss * (1.0f / 64.0f) + EPS);
            const size_t row = (size_t)(row0 + i);
#pragma unroll
            for (int ct = 0; ct < 4; ++ct) {
                const int c = ct * 16 + fq * 4;
                const u32x2 og = *(const u32x2*)(z + row * DZ + 1024 + h * 64 + c); const f32x4 gw = *(const f32x4*)(gnw + c);
                const float g0 = bf_lo(og.x), g1 = bf_hi(og.x), g2 = bf_lo(og.y), g3 = bf_hi(og.y);
                const float v0 = o[ct][0] * rstd * gw[0] * g0 * sigmoidf_(g0), v1 = o[ct][1] * rstd * gw[1] * g1 * sigmoidf_(g1);
                const float v2 = o[ct][2] * rstd * gw[2] * g2 * sigmoidf_(g2), v3 = o[ct][3] * rstd * gw[3] * g3 * sigmoidf_(g3);
                u32x2 w; w.x = pk_bf16(v0, v1); w.y = pk_bf16(v2, v3);
                *(u32x2*)(om + row * DM + h * 64 + c) = w;
            }
        }
    }
    __syncthreads();
}

__device__ __forceinline__ void gla_scan(const Params& p) {
    int tid = threadIdx.x; asm volatile("" : "+v"(tid));
    const int gtid = blockIdx.x * 512 + tid;
    if (gtid >= 65536) return;
    float* dS = (float*)(p.ws + W_DS); const float* egl = (const float*)(p.ws + W_EGL);
    const int b = gtid >> 14, h = (gtid >> 11) & 7, e = gtid & 2047;
    float S = 0.f;
    for (int n0 = 0; n0 < 128; n0 += 16) {
        float ds[16], eg[16];
#pragma unroll
        for (int u = 0; u < 16; ++u) { const size_t ci = (size_t)(b * 128 + n0 + u) * 8 + h; ds[u] = dS[ci * 2048 + e]; eg[u] = egl[ci * 32 + (e >> 6)]; }
#pragma unroll
        for (int u = 0; u < 16; ++u) { const size_t ci = (size_t)(b * 128 + n0 + u) * 8 + h; dS[ci * 2048 + e] = S; S = S * eg[u] + ds[u]; }
    }
    p.out[O_SGP + (size_t)(b * 8 + h) * 2048 + e] = S;
}

__device__ __forceinline__ void gla_sample_pair(const Params& p, LAS unsigned char* lds, int pair) {
    int tid = threadIdx.x; asm volatile("" : "+v"(tid));
    const int half = tid >> 8, t = tid & 255;
    const int item = pair * 2 + half, b = item >> 3, h = item & 7;
    const bf16_t* z = (const bf16_t*)(p.ws + W_Z); bf16_t* om = (bf16_t*)(p.ws + W_OM); const float* lr = (const float*)(p.ws + W_LR);
    LAS float* base = (LAS float*)(lds + half * 16384);
    LAS float* q = base; LAS float* k = base + 256; LAS float* a = base + 512; LAS float* v = base + 768; LAS float* red = base + 1280;
    const int rowb = NPROMPT + b * 8;
    {
        const int tt = t >> 5, d = t & 31; const bf16_t* zr = z + (size_t)(rowb + tt) * DZ;
        q[t] = bf2f(zr[h * 32 + d]) * 0.17677669529663687f; k[t] = bf2f(zr[256 + h * 32 + d]);
        float x = p.gate_b[h * 32 + d]; const float* lp = lr + (size_t)(rowb + tt) * 16;
#pragma unroll
        for (int r = 0; r < 16; ++r) x += lp[r] * p.gate_up[r * 256 + h * 32 + d];
        a[t] = __expf((fminf(x, 0.f) - __logf(1.0f + __expf(-fabsf(x)))) * (1.0f / 16.0f));
        const int c2 = (t & 31) * 2; v[tt * 64 + c2] = bf2f(zr[512 + h * 64 + c2]); v[tt * 64 + c2 + 1] = bf2f(zr[512 + h * 64 + c2 + 1]);
    }
    __syncthreads();
    const int dv = t & 63, g = t >> 6;
    float S[8];
    const size_t sb = ((size_t)(b * 8 + h) * 32 + g * 8) * 64 + dv;
#pragma unroll
    for (int i = 0; i < 8; ++i) S[i] = p.state[sb + i * 64];
#pragma unroll
    for (int tt = 0; tt < 8; ++tt) {
        float part = 0.f; const float vv = v[tt * 64 + dv];
#pragma unroll
        for (int i = 0; i < 8; ++i) { S[i] = a[tt * 32 + g * 8 + i] * S[i] + k[tt * 32 + g * 8 + i] * vv; part += q[tt * 32 + g * 8 + i] * S[i]; }
        red[(tt * 4 + g) * 64 + dv] = part;
    }
#pragma unroll
    for (int i = 0; i < 8; ++i) p.out[O_SGS + sb + i * 64] = S[i];
    __syncthreads();
#pragma unroll
    for (int u = 0; u < 2; ++u) {
        const int tt = g * 2 + u;
        const float o = red[(tt * 4 + 0) * 64 + dv] + red[(tt * 4 + 1) * 64 + dv] + red[(tt * 4 + 2) * 64 + dv] + red[(tt * 4 + 3) * 64 + dv];
        float ss = o * o;
#pragma unroll
        for (int m = 1; m < 64; m <<= 1) ss += __shfl_xor(ss, m);
        const float rstd = rsqrtf(ss * (1.0f / 64.0f) + EPS);
        const float og = bf2f(z[(size_t)(rowb + tt) * DZ + 1024 + h * 64 + dv]);
        om[(size_t)(rowb + tt) * DM + h * 64 + dv] = f2bf(o * rstd * p.gnw[dv] * og * sigmoidf_(og));
    }
    __syncthreads();
}

__device__ __forceinline__ void cache_outputs(const Params& p) {
    int tid = threadIdx.x; asm volatile("" : "+v"(tid));
    const int gtid = blockIdx.x * 512 + tid, gthreads = gridDim.x * 512;
    const bf16_t* z = (const bf16_t*)(p.ws + W_Z);
    for (int i4 = gtid; i4 < 16384; i4 += gthreads) {
        const int i = i4 * 4, c = i & 127, j = (i >> 7) & 127, b = i >> 14;
        const bf16_t* zr = z + (size_t)(b * 8192 + 8064 + j) * DZ;
        const u32x2 kq = *(const u32x2*)(zr + 2048 + c), vq = *(const u32x2*)(zr + 2176 + c);
        *(f32x4*)(p.out + O_CKP + i) = (f32x4){bf_lo(kq.x), bf_hi(kq.x), bf_lo(kq.y), bf_hi(kq.y)};
        *(f32x4*)(p.out + O_CVP + i) = (f32x4){bf_lo(vq.x), bf_hi(vq.x), bf_lo(vq.y), bf_hi(vq.y)};
    }
#pragma unroll 4
    for (int i4 = gtid; i4 < 524288; i4 += gthreads) {
        const int i = i4 * 4, c = i & 127, j = (i >> 7) & 127, b = i >> 14;
        f32x4 kvv, vvv;
        if (j < 120) { kvv = *(const f32x4*)(p.ck + (size_t)(b * 128 + j + 8) * 128 + c); vvv = *(const f32x4*)(p.cv + (size_t)(b * 128 + j + 8) * 128 + c); }
        else { const bf16_t* zr = z + (size_t)(NPROMPT + b * 8 + j - 120) * DZ; const u32x2 kq = *(const u32x2*)(zr + 2048 + c), vq = *(const u32x2*)(zr + 2176 + c);
               kvv = (f32x4){bf_lo(kq.x), bf_hi(kq.x), bf_lo(kq.y), bf_hi(kq.y)}; vvv = (f32x4){bf_lo(vq.x), bf_hi(vq.x), bf_lo(vq.y), bf_hi(vq.y)}; }
        *(f32x4*)(p.out + O_CKS + i) = kvv; *(f32x4*)(p.out + O_CVS + i) = vvv;
    }
}

template <bool SECOND>
__device__ __forceinline__ void ew_phase(const Params& p) {
    int tid = threadIdx.x; asm volatile("" : "+v"(tid));
    const int lane = tid & 63, wid = tid >> 6;
    const int gw = blockIdx.x * 8 + wid, nw = gridDim.x * 8;
    constexpr int NS = SECOND ? 11 : 4;
    const bf16_t* br = (const bf16_t*)(p.ws + W_MIX); const float* part = (const float*)(p.ws + (SECOND ? W_PART2 : W_PART1));
    const float* w = SECOND ? p.w_post_ffn : p.w_post_mix;
    bf16_t* hb = (bf16_t*)(p.ws + W_XB); float* rsh = (float*)(p.ws + W_RSH);
    f32x4 w4[4];
#pragma unroll
    for (int i = 0; i < 4; ++i) w4[i] = *(const f32x4*)(w + i * 256 + lane * 4);
    for (int row = gw; row < NTOK; row += nw) {
        f32x4 m4[4], x4[4];
        if (SECOND) {
#pragma unroll
            for (int i = 0; i < 4; ++i) { const u32x2 hq = *(const u32x2*)(hb + (size_t)row * DM + i * 256 + lane * 4); x4[i] = (f32x4){bf_lo(hq.x), bf_hi(hq.x), bf_lo(hq.y), bf_hi(hq.y)}; }
        } else {
            const float* xr = row < NPROMPT ? p.xp + (size_t)row * DM : p.xs + (size_t)(row - NPROMPT) * DM;
#pragma unroll
            for (int i = 0; i < 4; ++i) x4[i] = *(const f32x4*)(xr + i * 256 + lane * 4);
        }
        if (row < NPROMPT) {
#pragma unroll
            for (int i = 0; i < 4; ++i) { const u32x2 mq = *(const u32x2*)(br + (size_t)row * DM + i * 256 + lane * 4); m4[i] = (f32x4){bf_lo(mq.x), bf_hi(mq.x), bf_lo(mq.y), bf_hi(mq.y)}; }
        } else {
            const float* pr = part + (size_t)(row - NPROMPT) * DM + lane * 4;
#pragma unroll
            for (int i = 0; i < 4; ++i) m4[i] = *(const f32x4*)(pr + i * 256);
#pragma unroll 1
            for (int sidx = 1; sidx < NS; ++sidx) {
#pragma unroll
                for (int i = 0; i < 4; ++i) m4[i] += *(const f32x4*)(pr + (size_t)sidx * 1048576 + i * 256);
            }
        }
        float s1 = 0.f;
#pragma unroll
        for (int i = 0; i < 4; ++i) s1 += m4[i][0] * m4[i][0] + m4[i][1] * m4[i][1] + m4[i][2] * m4[i][2] + m4[i][3] * m4[i][3];
#pragma unroll
        for (int o = 1; o < 64; o <<= 1) s1 += __shfl_xor(s1, o);
        const float rs = rsqrtf(s1 * (1.0f / 1024.0f) + EPS);
        float s2 = 0.f;
#pragma unroll
        for (int i = 0; i < 4; ++i) {
            const f32x4 h4 = x4[i] + m4[i] * rs * w4[i];
            u32x2 wv; wv.x = pk_bf16(h4[0], h4[1]); wv.y = pk_bf16(h4[2], h4[3]); *(u32x2*)(hb + (size_t)row * DM + i * 256 + lane * 4) = wv;
            s2 += h4[0] * h4[0] + h4[1] * h4[1] + h4[2] * h4[2] + h4[3] * h4[3];
        }
        if (!SECOND) {
#pragma unroll
            for (int o = 1; o < 64; o <<= 1) s2 += __shfl_xor(s2, o);
            if (lane == 0) rsh[row] = rsqrtf(s2 * (1.0f / 1024.0f) + EPS);
        }
    }
}

__global__ void __launch_bounds__(512, 2) mega(Params p_in) {
    const Params* pq = (const Params*)__builtin_amdgcn_kernarg_segment_ptr();
#define LAUNDER() asm volatile("" : "+s"(pq))
#define p (*pq)
    extern __shared__ __attribute__((aligned(16))) unsigned char shm[];
    LAS unsigned char* lds = (LAS unsigned char*)shm;
    cg::grid_group grid = cg::this_grid();
    const int G = gridDim.x, c = blockIdx.x;
#define ws (pq->ws)

#ifndef PHASES
#define PHASES 0xffff
#endif
#define PH(k) if constexpr ((PHASES >> (k)) & 1)
    volatile LAS unsigned* bst = (volatile LAS unsigned*)(lds + 131072);
    if (threadIdx.x == 0) { bst[0] = 0u; bst[1] = 0u; }
    __syncthreads();
    const XcdBarrier xb = xcd_barrier_post((unsigned*)(ws + W_BAR), bst);
#define GBAR() do { xcd_barrier(xb); LAUNDER(); } while (0)
    PH(0) phase_prep(p, lds);
    if (p.out == nullptr) grid.sync();
    GBAR();
    PH(1) { pg8::StaticOrder S; S.init(NTOK, DZ, 1024, G, c); pg8::Gemm g{(const bf16_t*)(ws + W_XB), (const bf16_t*)(ws + W_WIN), NTOK, DZ, 1024};
      EpiBf16Scale E{(bf16_t*)(ws + W_Z), DZ, (const float*)(ws + W_RSX)}; pg8::gemm_phase(lds, g, S, E); }
    GBAR();
    PH(2) for (int it = c; it < 1024; it += G) swa_item<false>(p, lds, it);
    PH(3) for (int it = c; it < 128; it += G) swa_item<true>(p, lds, it);
    PH(4) for (int it = c; it < 1024; it += G) gla_prompt_item<false>(p, lds, it);
    PH(5) for (int it = c; it < 512; it += G) gla_sample_pair(p, lds, it);
    PH(6) cache_outputs(p);
    GBAR();
    PH(7) gla_scan(p);
    GBAR();
    PH(8) for (int it = c; it < 1024; it += G) gla_prompt_item<true>(p, lds, it);
    GBAR();
    PH(9) { pg8::StaticOrder S; S.init(NPROMPT, DM, 1024, G, c); pg8::Gemm g{(const bf16_t*)(ws + W_OM), (const bf16_t*)(ws + W_WOUT), NTOK, DM, 1024};
      EpiBf16Scale E{(bf16_t*)(ws + W_MIX), DM, (const float*)nullptr}; pg8::gemm_phase(lds, g, S, E); }
    PH(9) { pg8::SplitOrder S; S.init(128, 4, 4, 4, 4, G, c - 64); pg8::Gemm g{(const bf16_t*)(ws + W_OM), (const bf16_t*)(ws + W_WOUT), NTOK, DM, 1024};
      EpiF32Part E{(float*)(ws + W_PART1), NPROMPT, 4}; pg8::gemm_phase(lds, g, S, E); }
    PH(12) { pg8::StaticOrder S; S.init(NTOK, DM, 256, G, c); pg8::Gemm g{(const bf16_t*)(ws + W_PB), (const bf16_t*)(ws + W_WPP), NTOK, DM, 256};
      EpiBf16Scale E{(bf16_t*)(ws + W_PP), DM, (const float*)nullptr}; pg8::gemm_phase(lds, g, S, E); }
    GBAR();
    PH(10) ew_phase<false>(p);
    GBAR();
    PH(11) { pg8::StaticOrder S; S.init(NTOK, 5632, 1024, G, c); pg8::Gemm g{(const bf16_t*)(ws + W_XB), (const bf16_t*)(ws + W_WGU), NTOK, 5632, 1024};
      EpiAct E{(bf16_t*)(ws + W_Z), (const float*)(ws + W_RSH)}; pg8::gemm_phase(lds, g, S, E); }
    GBAR();
    PH(13) { pg8::StaticOrder S; S.init(NPROMPT, DM, DFF, G, c); pg8::Gemm g{(const bf16_t*)(ws + W_Z), (const bf16_t*)(ws + W_WDN), NTOK, DM, DFF};
      EpiBf16Scale E{(bf16_t*)(ws + W_MIX), DM, (const float*)nullptr}; pg8::gemm_phase(lds, g, S, E); }
    PH(13) { pg8::SplitOrder S; S.init(128, 4, 4, 11, 4, G, c); pg8::Gemm g{(const bf16_t*)(ws + W_Z), (const bf16_t*)(ws + W_WDN), NTOK, DM, DFF};
      EpiF32Part E{(float*)(ws + W_PART2), NPROMPT, 4}; pg8::gemm_phase(lds, g, S, E); }
    GBAR();
    PH(14) ew_phase<true>(p);
    GBAR();
    PH(15) { pg8::StaticOrder S; S.init(NTOK, DM, 1024, G, c); pg8::Gemm g{(const bf16_t*)(ws + W_XB), (const bf16_t*)(ws + W_WPG), NTOK, DM, 1024};
      EpiOut E{p.out + O_Y, (const bf16_t*)(ws + W_PP), (const bf16_t*)(ws + W_XB)}; pg8::gemm_phase(lds, g, S, E); }
#undef GBAR
#undef ws
#undef p
#undef LAUNDER
}

extern "C" void kernel_launch(void* const* d_in, const int* in_sizes, int n_in, void* d_out, int out_size, void* d_ws, size_t ws_size, hipStream_t stream) {
    static int grid_blocks = 0;
    if (!grid_blocks) {
        int dev = 0, cus = 0, per_cu = 0;
        hipGetDevice(&dev);
        hipDeviceGetAttribute(&cus, hipDeviceAttributeMultiprocessorCount, dev);
        hipFuncSetAttribute((const void*)mega, hipFuncAttributeMaxDynamicSharedMemorySize, LDS_BYTES);
        hipOccupancyMaxActiveBlocksPerMultiprocessor(&per_cu, mega, 512, LDS_BYTES);
        if (per_cu < 1) per_cu = 1;
        grid_blocks = cus;
        if (grid_blocks > cus * per_cu) grid_blocks = cus * per_cu;
        if (ws_size < W_END) fprintf(stderr, "workspace too small: %zu < %zu\n", ws_size, (size_t)W_END);
    }
    Params p{};
    p.xp = (const float*)d_in[0]; p.xs = (const float*)d_in[1]; p.pp = (const float*)d_in[2]; p.ps = (const float*)d_in[3];
    p.state = (const float*)d_in[4]; p.ck = (const float*)d_in[5]; p.cv = (const float*)d_in[6];
    p.w_pre_mix = (const float*)d_in[7]; p.w_in = (const float*)d_in[8]; p.gate_up = (const float*)d_in[9]; p.gate_b = (const float*)d_in[10];
    p.gnw = (const float*)d_in[11]; p.sinks = (const float*)d_in[12]; p.w_out = (const float*)d_in[13]; p.w_post_mix = (const float*)d_in[14];
    p.w_pre_ffn = (const float*)d_in[15]; p.w_gate = (const float*)d_in[16]; p.w_up = (const float*)d_in[17]; p.w_down = (const float*)d_in[18];
    p.w_post_ffn = (const float*)d_in[19]; p.w_ple_gate = (const float*)d_in[20]; p.w_ple_proj = (const float*)d_in[21];
    p.out = (float*)d_out; p.ws = (unsigned char*)d_ws;
    (void)hipMemsetAsync((unsigned char*)d_ws + W_BAR, 0, 16384, stream);
    void* args[] = {&p};
    hipError_t e = hipLaunchCooperativeKernel((const void*)mega, dim3(grid_blocks), dim3(512), args, LDS_BYTES, stream);
    if (e != hipSuccess) fprintf(stderr, "cooperative launch failed: %s (grid %d)\n", hipGetErrorString(e), grid_blocks);
}
```
